# Optimizing an MI355X kernel written in HIP

```python
import math
import jax, jax.numpy as jnp
from jax import lax
import numpy as np

D_MODEL = 2048
BATCH = 8
SEQ = 4096
DEPTH = 1
DEC_BATCH = 16
DEC_SEQ = 32
PAST_LEN = 4096

CHUNK = 64
MIX_WIDTH = D_MODEL
FOX_WIDTH = MIX_WIDTH // 2
FOX_HEADS = 8
FOX_HEAD_DIM = FOX_WIDTH // FOX_HEADS
GMLP_WIDTH = MIX_WIDTH - FOX_WIDTH
GMLP_GROUPS = 4
GMLP_GROUP_DIM = GMLP_WIDTH // GMLP_GROUPS
GMLP_CHUNK = 2 * CHUNK
Q_BLOCK = 128
N_MEM = 256
MEM_HEADS = 4
MEM_HEAD_DIM = D_MODEL // MEM_HEADS
D_FF = 4 * D_MODEL
ALPHA = (2 * DEPTH) ** 0.25
BETA = (8 * DEPTH) ** -0.25
LN_EPS = 1e-5
IN_COLS = 3 * FOX_WIDTH + FOX_HEADS + 2 * GMLP_WIDTH
FOX_SCALE = FOX_HEAD_DIM ** -0.5
MEM_SCALE = MEM_HEAD_DIM ** -0.5

kernel_name = "fox_gmlp_hybrid_stream_step"


def layer_norm(x, g, b):
    xf = x.astype(jnp.float32)
    mu = jnp.mean(xf, axis=-1, keepdims=True)
    var = jnp.mean(jnp.square(xf - mu), axis=-1, keepdims=True)
    return ((xf - mu) * lax.rsqrt(var + LN_EPS) * g.astype(jnp.float32) + b.astype(jnp.float32)).astype(x.dtype)


def project_in(x, w_in, b_f, sgu_g, sgu_b):
    B, T, _ = x.shape
    z = x @ w_in
    o1, o2, o3 = FOX_WIDTH, 2 * FOX_WIDTH, 3 * FOX_WIDTH
    o4 = o3 + FOX_HEADS
    o5 = o4 + GMLP_WIDTH
    q = z[..., :o1].reshape(B, T, FOX_HEADS, FOX_HEAD_DIM)
    k = z[..., o1:o2].reshape(B, T, FOX_HEADS, FOX_HEAD_DIM)
    v = z[..., o2:o3].reshape(B, T, FOX_HEADS, FOX_HEAD_DIM)
    logf = jax.nn.log_sigmoid((z[..., o3:o4] + b_f).astype(jnp.float32))
    u = jax.nn.gelu(z[..., o4:o5])
    g = layer_norm(jax.nn.gelu(z[..., o5:]), sgu_g, sgu_b)
    return q, k, v, logf, u, g


def fox_block(q, k, v, c_q, c_k, q_pos, k_pos):
    s = jnp.einsum('bqhd,bkhd->bhqk', q, k).astype(jnp.float32) * FOX_SCALE
    s = s + (jnp.transpose(c_q, (0, 2, 1))[..., :, None] - jnp.transpose(c_k, (0, 2, 1))[..., None, :])
    mask = k_pos[None, :] <= q_pos[:, None]
    s = jnp.where(mask, s, -jnp.inf)
    p = jax.nn.softmax(s, axis=-1)
    return jnp.einsum('bhqk,bkhd->bqhd', p.astype(v.dtype), v)


def fox_prompt(q, k, v, logf):
    S = q.shape[1]
    c = jnp.cumsum(logf, axis=1)
    outs = []
    for i in range(S // Q_BLOCK):
        lo, hi = i * Q_BLOCK, (i + 1) * Q_BLOCK
        outs.append(fox_block(q[:, lo:hi], k[:, :hi], v[:, :hi], c[:, lo:hi], c[:, :hi],
                              jnp.arange(lo, hi), jnp.arange(hi)))
    return jnp.concatenate(outs, axis=1)


def fox_sample(q, k, v, logf, cache_k, cache_v, cache_logf):
    P, T = cache_k.shape[1], q.shape[1]
    k_all = jnp.concatenate([cache_k, k.astype(cache_k.dtype)], axis=1)
    v_all = jnp.concatenate([cache_v, v.astype(cache_v.dtype)], axis=1)
    c = jnp.cumsum(jnp.concatenate([cache_logf.astype(jnp.float32), logf], axis=1), axis=1)
    return fox_block(q, k_all, v_all, c[:, P:], c, jnp.arange(P, P + T), jnp.arange(P + T))


def sgu_prompt(u, g, w_s, b_s):
    B, S, _ = u.shape
    n = S // GMLP_CHUNK
    ws = w_s * jnp.tril(jnp.ones((GMLP_CHUNK, GMLP_CHUNK), w_s.dtype))
    gr = g.reshape(B, n, GMLP_CHUNK, GMLP_GROUPS, GMLP_GROUP_DIM)
    s = jnp.einsum('gts,bnsgc->bntgc', ws, gr) + jnp.transpose(b_s)[None, None, :, :, None]
    return u * s.reshape(B, S, GMLP_WIDTH)


def sgu_sample(u, g, w_s, b_s):
    B, T, _ = u.shape
    ws = (w_s * jnp.tril(jnp.ones((GMLP_CHUNK, GMLP_CHUNK), w_s.dtype)))[:, :T, :T]
    gr = g.reshape(B, T, GMLP_GROUPS, GMLP_GROUP_DIM)
    s = jnp.einsum('gts,bsgc->btgc', ws, gr) + jnp.transpose(b_s[:, :T])[None, :, :, None]
    return u * s.reshape(B, T, GMLP_WIDTH)


def mem_kv(mem, w_mk, w_mv):
    B, M, _ = mem.shape
    return ((mem @ w_mk).reshape(B, M, MEM_HEADS, MEM_HEAD_DIM),
            (mem @ w_mv).reshape(B, M, MEM_HEADS, MEM_HEAD_DIM))


def mem_attend(x, mk, mv, w_mq, w_mo):
    B, T, _ = x.shape
    q = (x @ w_mq).reshape(B, T, MEM_HEADS, MEM_HEAD_DIM)
    s = jnp.einsum('bqhd,bkhd->bhqk', q, mk.astype(q.dtype)).astype(jnp.float32) * MEM_SCALE
    p = jax.nn.softmax(s, axis=-1)
    o = jnp.einsum('bhqk,bkhd->bqhd', p.astype(q.dtype), mv.astype(q.dtype))
    return o.reshape(B, T, D_MODEL) @ w_mo


def ffn(x, w_up, w_down):
    return jnp.square(jax.nn.relu(x @ w_up)) @ w_down


def post_sublayers(h, mix, mk, mv, l, ln1_g, ln1_b, w_mq, w_mo, ln2_g, ln2_b, w_up, w_down, ln3_g, ln3_b):
    h = layer_norm(ALPHA * h + mix, ln1_g[l], ln1_b[l])
    h = layer_norm(ALPHA * h + mem_attend(h, mk, mv, w_mq[l], w_mo[l]), ln2_g[l], ln2_b[l])
    return layer_norm(ALPHA * h + ffn(h, w_up[l], w_down[l]), ln3_g[l], ln3_b[l])


def setup_inputs(seed: int = 0) -> dict:
    key = jax.random.key(seed)
    ks = iter(jax.random.split(key, 40))
    nrm = lambda shape, s=1.0: jax.random.normal(next(ks), shape, jnp.float32) * s
    L = DEPTH
    return {
        "x_prompt": nrm((BATCH, SEQ, D_MODEL)),
        "x_sample": nrm((DEC_BATCH, DEC_SEQ, D_MODEL)),
        "mem_prompt": nrm((BATCH, N_MEM, D_MODEL)),
        "cache_fox_k": nrm((L, DEC_BATCH, PAST_LEN, FOX_HEADS, FOX_HEAD_DIM)),
        "cache_fox_v": nrm((L, DEC_BATCH, PAST_LEN, FOX_HEADS, FOX_HEAD_DIM)),
        "cache_fox_logf": jax.nn.log_sigmoid(2.0 + nrm((L, DEC_BATCH, PAST_LEN, FOX_HEADS))),
        "cache_mem_k": nrm((L, DEC_BATCH, N_MEM, MEM_HEADS, MEM_HEAD_DIM)),
        "cache_mem_v": nrm((L, DEC_BATCH, N_MEM, MEM_HEADS, MEM_HEAD_DIM)),
        "w_in": nrm((L, D_MODEL, IN_COLS), D_MODEL ** -0.5),
        "b_f": 2.0 + nrm((L, FOX_HEADS), 0.1),
        "sgu_ln_g": 1.0 + nrm((L, GMLP_WIDTH), 0.01),
        "sgu_ln_b": nrm((L, GMLP_WIDTH), 0.01),
        "w_s": nrm((L, GMLP_GROUPS, GMLP_CHUNK, GMLP_CHUNK), GMLP_CHUNK ** -0.5),
        "b_s": 1.0 + nrm((L, GMLP_GROUPS, GMLP_CHUNK), 0.01),
        "w_out": nrm((L, MIX_WIDTH, D_MODEL), BETA * MIX_WIDTH ** -0.5),
        "ln1_g": 1.0 + nrm((L, D_MODEL), 0.01),
        "ln1_b": nrm((L, D_MODEL), 0.01),
        "w_mq": nrm((L, D_MODEL, D_MODEL), D_MODEL ** -0.5),
        "w_mk": nrm((L, D_MODEL, D_MODEL), D_MODEL ** -0.5),
        "w_mv": nrm((L, D_MODEL, D_MODEL), D_MODEL ** -0.5),
        "w_mo": nrm((L, D_MODEL, D_MODEL), BETA * D_MODEL ** -0.5),
        "ln2_g": 1.0 + nrm((L, D_MODEL), 0.01),
        "ln2_b": nrm((L, D_MODEL), 0.01),
        "w_up": nrm((L, D_MODEL, D_FF), D_MODEL ** -0.5),
        "w_down": nrm((L, D_FF, D_MODEL), BETA * D_FF ** -0.5),
        "ln3_g": 1.0 + nrm((L, D_MODEL), 0.01),
        "ln3_b": nrm((L, D_MODEL), 0.01),
    }


def reference(x_prompt, x_sample, mem_prompt, cache_fox_k, cache_fox_v, cache_fox_logf,
              cache_mem_k, cache_mem_v, w_in, b_f, sgu_ln_g, sgu_ln_b, w_s, b_s, w_out,
              ln1_g, ln1_b, w_mq, w_mk, w_mv, w_mo, ln2_g, ln2_b, w_up, w_down, ln3_g, ln3_b):
    hp, hs = x_prompt, x_sample
    fkp, fvp, flp, mkp, mvp = [], [], [], [], []
    fks, fvs, fls, gvs = [], [], [], []
    for l in range(DEPTH):
        B, S, _ = hp.shape
        q, k, v, logf, u, g = project_in(hp, w_in[l], b_f[l], sgu_ln_g[l], sgu_ln_b[l])
        fo = fox_prompt(q, k, v, logf).reshape(B, S, FOX_WIDTH)
        go = sgu_prompt(u, g, w_s[l], b_s[l])
        mix = jnp.concatenate([fo, go], axis=-1) @ w_out[l]
        mk, mv = mem_kv(mem_prompt, w_mk[l], w_mv[l])
        fkp.append(k); fvp.append(v); flp.append(logf); mkp.append(mk); mvp.append(mv)
        hp = post_sublayers(hp, mix, mk, mv, l, ln1_g, ln1_b, w_mq, w_mo, ln2_g, ln2_b,
                            w_up, w_down, ln3_g, ln3_b)
        Bs, T, _ = hs.shape
        q, k, v, logf, u, g = project_in(hs, w_in[l], b_f[l], sgu_ln_g[l], sgu_ln_b[l])
        fo = fox_sample(q, k, v, logf, cache_fox_k[l], cache_fox_v[l], cache_fox_logf[l]).reshape(Bs, T, FOX_WIDTH)
        go = sgu_sample(u, g, w_s[l], b_s[l])
        mix = jnp.concatenate([fo, go], axis=-1) @ w_out[l]
        fks.append(k); fvs.append(v); fls.append(logf); gvs.append(g)
        hs = post_sublayers(hs, mix, cache_mem_k[l], cache_mem_v[l], l, ln1_g, ln1_b, w_mq, w_mo,
                            ln2_g, ln2_b, w_up, w_down, ln3_g, ln3_b)
    return (hp, hs, jnp.stack(fkp), jnp.stack(fvp), jnp.stack(flp), jnp.stack(mkp), jnp.stack(mvp),
            jnp.stack(fks), jnp.stack(fvs), jnp.stack(fls), jnp.stack(gvs))
```

```cpp
#include <hip/hip_runtime.h>
#include <hip/hip_bf16.h>
#include <cstdio>
#include <cstdint>

#ifndef MK_N_LAUNCHES
#define MK_N_LAUNCHES 1
#define PROBE_P2_SUB 3
#define PROBE_REPEAT 0
#endif
#ifndef PROBE_FIX_AMASK
#define PROBE_FIX_AMASK 0
#define PROBE_FIX_BMASK 0
#endif

#define GAS __attribute__((address_space(1)))
#define LAS __attribute__((address_space(3)))
typedef unsigned short bf16_t;
typedef short bf16x8 __attribute__((ext_vector_type(8)));
typedef short s16x4 __attribute__((ext_vector_type(4)));
typedef float f32x2 __attribute__((ext_vector_type(2)));
typedef float f32x4 __attribute__((ext_vector_type(4)));
typedef float f32x16 __attribute__((ext_vector_type(16)));
typedef unsigned u32x2 __attribute__((ext_vector_type(2)));
typedef unsigned u32x4 __attribute__((ext_vector_type(4)));
typedef GAS unsigned gu32;

constexpr int DM = 2048, NB = 8, SEQ = 4096, MP = NB * SEQ, NBS = 16, TS = 32, MS = NBS * TS, MT = MP + MS, PAST = 4096;
constexpr int FW = 1024, FH = 8, FD = 128, GW = 1024, NMEM = 256, MH = 4, MD = 512, DFF = 8192, INC = 5128, NIN = 5120;
constexpr int SKS = 4160;
constexpr int MPAD = MT + 256;
constexpr float ALPHA = 1.189207115002721f;
constexpr float LN_EPS = 1e-5f;
constexpr float FOX_SCALE = 0.08838834764831845f;
constexpr float MEM_SCALE = 0.04419417382415922f;
constexpr float LOG2E = 1.4426950408889634f;

constexpr size_t O_YP = 0, O_YS = 67108864, O_FKP = 68157440, O_FVP = 101711872, O_FLP = 135266304, O_MKP = 135528448, O_MVP = 139722752,
                 O_FKS = 143917056, O_FVS = 144441344, O_FLS = 144965632, O_GVS = 144969728, O_END = 145494016;

constexpr size_t MiB = 1u << 20;
constexpr size_t WS_CTL = 0, CTL_ZERO_BYTES = 1 * MiB;
constexpr size_t WS_KXP = 1 * MiB, WS_KXS = 3 * MiB;
constexpr size_t WS_WIN = 8 * MiB, WS_WOUT = 28 * MiB, WS_WMQ = 36 * MiB, WS_WMK = 44 * MiB, WS_WMV = 52 * MiB, WS_WMO = 60 * MiB, WS_WUP = 68 * MiB, WS_WDN = 100 * MiB;
constexpr size_t WS_MEMB = 132 * MiB, WS_MKB = 140 * MiB, WS_MVB = 148 * MiB, WS_CMK = 156 * MiB, WS_CMVT = 172 * MiB;
constexpr size_t WS_XB = 188 * MiB, WS_QB = 318 * MiB, WS_KB = 384 * MiB, WS_VB = 449 * MiB, WS_UB = 514 * MiB, WS_GB = 579 * MiB;
constexpr size_t WS_HB = 188 * MiB;
constexpr size_t WS_KS = 708 * MiB, WS_VS = 838 * MiB;
constexpr size_t WS_FOGO = 188 * MiB;
constexpr size_t WS_XLB = 708 * MiB;
constexpr size_t WS_QM = 838 * MiB;
constexpr size_t WS_PB = 188 * MiB;
constexpr size_t WS_OM = 318 * MiB;
constexpr size_t WS_MT = 448 * MiB, WS_VWT = 480 * MiB;
constexpr size_t WS_WMQN = 1040 * MiB;
constexpr size_t WS_CSM = 1039 * MiB + 512 * 1024;
constexpr size_t WS_SLAB = 970 * MiB;
constexpr size_t WS_STAT1 = 1034 * MiB, WS_STAT2 = 1037 * MiB;
constexpr size_t WS_END = 1048 * MiB;
static_assert(WS_QB + (size_t)MPAD * 1024 * 2 <= WS_KB && WS_GB + (size_t)MT * 1024 * 2 <= WS_KS && WS_HB + (size_t)MT * DFF * 2 <= WS_KS, "ws map A");
static_assert(WS_VS + (size_t)NBS * SKS * 1024 * 2 <= WS_SLAB && WS_QM + (size_t)MPAD * 2048 * 2 <= WS_SLAB && WS_PB + (size_t)MPAD * 1024 * 2 <= WS_QB, "ws map B");
static_assert(WS_KXS + (size_t)NBS * FH * SKS * 8 <= WS_WIN && WS_KXP + (size_t)NB * FH * SEQ * 8 <= WS_KXS, "ws map C");

constexpr int CW_BAR = 4096;
constexpr int CW_QN2 = 8192, CW_KN2 = CW_QN2 + 192 * 4, CW_KN2C = CW_KN2 + 192 * 4;
constexpr int CW_CS1 = 16384, CW_BW1 = CW_CS1 + 2048, CW_CS2 = CW_BW1 + 2048, CW_BW2 = CW_CS2 + 8192;
static_assert((CW_BW2 + 8192) * 4 <= (int)CTL_ZERO_BYTES, "CTL words");
constexpr float PRUNE_T = 20.0f;

constexpr int RING_BYTES = 131072;
constexpr int LDSCTL_OFF = RING_BYTES, MISC_OFF = LDSCTL_OFF + 320, XCH_OFF = RING_BYTES + 1024;
constexpr int LDS_BYTES = 147456;
constexpr int NWAVES = 8;

#define LDS_WAIT() asm volatile("s_waitcnt lgkmcnt(0)" ::: "memory")
#define VM_WAIT() asm volatile("s_waitcnt vmcnt(0)" ::: "memory")

__device__ __forceinline__ unsigned cvt_pk_bf16(float lo, float hi) { unsigned r; asm volatile("v_cvt_pk_bf16_f32 %0, %1, %2" : "=v"(r) : "v"(lo), "v"(hi)); return r; }
__device__ __forceinline__ float bf2f(unsigned short h) { return __uint_as_float(((unsigned)h) << 16); }
__device__ __forceinline__ unsigned short f2bf(float f) { unsigned u = __float_as_uint(f); return (unsigned short)((u + 0x7fffu + ((u >> 16) & 1u)) >> 16); }

__device__ __forceinline__ int lane_id() { return (int)__builtin_amdgcn_mbcnt_hi(~0u, __builtin_amdgcn_mbcnt_lo(~0u, 0u)); }
__device__ __forceinline__ float shflx(float v, int m) { int l = lane_id(); asm volatile("" : "+v"(l)); return __int_as_float(__builtin_amdgcn_ds_bpermute((l ^ m) << 2, __float_as_int(v))); }
#define __shfl_xor(v, m) shflx((v), (m))

#define XB_TMO      128
#define XB_XCNT(j)  (256  + 64 * (j))
#define XB_XSUB(j)  (1280 + 64 * (j))
#define XB_XGEN(j)  (2304 + 64 * (j))
#define XB_TOP      3328
#define XB_TOPGEN   3392
#define XCD_BAR_WORDS 3456
#define XB_SPIN_CAP (1u << 18)

__device__ __forceinline__ unsigned xb_ld(unsigned* p)              { return __hip_atomic_load(p, __ATOMIC_RELAXED, __HIP_MEMORY_SCOPE_AGENT); }
__device__ __forceinline__ unsigned xb_add(unsigned* p, unsigned v) { return __hip_atomic_fetch_add(p, v, __ATOMIC_RELAXED, __HIP_MEMORY_SCOPE_AGENT); }
__device__ __forceinline__ unsigned xb_xcc_id() { return (unsigned)__builtin_amdgcn_s_getreg((3 << 11) | 20) & 0xFu; }
#define XB_SPIN(cond, bar) do { unsigned _sp = 0; while (cond) { __builtin_amdgcn_s_sleep(1); \
    if ((++_sp & 255u) == 0u) { if (xb_ld(&(bar)[XB_TMO])) break; if (_sp > XB_SPIN_CAP) { atomicAdd(&(bar)[XB_TMO], 1u); break; } } } } while (0)

struct XcdBarrier { unsigned* bar; unsigned x; volatile LAS unsigned* st; unsigned G; bool t0; };

__device__ __forceinline__ XcdBarrier xcd_barrier_post(unsigned* bar, volatile LAS unsigned* st, bool t0) {
    XcdBarrier b; b.bar = bar; b.x = xb_xcc_id(); b.st = st;
    if (t0) (void)xb_add(&bar[XB_XCNT(b.x)], 1u);
    return b;
}
__device__ __forceinline__ void xcd_barrier_complete(unsigned* bar, unsigned x, unsigned G, unsigned& nloc, unsigned& nx) {
    unsigned sum, cnt, mine, sp = 0u;
    for (;;) {
        sum = 0u; cnt = 0u; mine = 0u;
#pragma unroll
        for (unsigned j = 0; j < 16; ++j) { const unsigned c = xb_ld(&bar[XB_XCNT(j)]); sum += c; cnt += (c > 0u) ? 1u : 0u; mine = (j == x) ? c : mine; }
        if (sum == G) break;
        __builtin_amdgcn_s_sleep(1);
        if ((++sp & 255u) == 0u) { if (xb_ld(&bar[XB_TMO])) break; if (sp > XB_SPIN_CAP) { atomicAdd(&bar[XB_TMO], 1u); break; } }
    }
    nloc = mine > 0u ? mine : 1u; nx = cnt > 0u ? cnt : 1u;
}
__device__ __forceinline__ void xcd_barrier(const XcdBarrier& b) {
    asm volatile("s_waitcnt vmcnt(0)" ::: "memory");
    __syncthreads();
    if (b.t0) {
        unsigned* bar = b.bar;
        __builtin_amdgcn_s_waitcnt(0);
        unsigned nloc = b.st[0], nx = b.st[1];
        if (nloc == 0u) { xcd_barrier_complete(bar, b.x, b.G, nloc, nx); b.st[0] = nloc; b.st[1] = nx; }
        const unsigned old = xb_add(&bar[XB_XSUB(b.x)], 1u);
        const unsigned gen = old / nloc;
        if (old + 1u == (gen + 1u) * nloc) {
            __builtin_amdgcn_fence(__ATOMIC_RELEASE, "agent");
            asm volatile("s_waitcnt vmcnt(0)" ::: "memory");
            const unsigned og = xb_add(&bar[XB_TOP], 1u);
            const unsigned tg = og / nx;
            if (og + 1u == (tg + 1u) * nx) xb_add(&bar[XB_TOPGEN], 1u);
            else XB_SPIN(xb_ld(&bar[XB_TOPGEN]) == tg, bar);
            __builtin_amdgcn_fence(__ATOMIC_ACQUIRE, "agent");
            xb_add(&bar[XB_XGEN(b.x)], 1u);
            asm volatile("s_waitcnt vmcnt(0)" ::: "memory");
        } else {
            XB_SPIN(xb_ld(&bar[XB_XGEN(b.x)]) == gen, bar);
            __builtin_amdgcn_fence(__ATOMIC_ACQUIRE, "agent");
            asm volatile("s_waitcnt vmcnt(0)" ::: "memory");
        }
    }
    __syncthreads();
}

#ifndef PG8_SP2
#define PG8_SP2 true
#endif
namespace pg8 {
constexpr int BM = 256, BK = 64, HALF = 128, HTB = HALF * BK * 2, STAGE_BYTES = 8 * HTB, NXCD = 8, WGM = 8;
__host__ __device__ __forceinline__ int lds_byte(int r, int c) { const int st = (r >> 4) * 2 + (c >> 5), rr = r & 15, cc = c & 31, ob = rr * 64 + cc * 2; return st * 1024 + (ob ^ (((ob >> 9) & 1) << 5)); }
__host__ __device__ __forceinline__ void stage_rc(int b, int& R, int& C) { const int st = b / 1024, sb = b % 1024, swz = sb ^ (((sb >> 9) & 1) << 5); R = (st >> 1) * 16 + swz / 64; C = (st & 1) * 32 + (swz % 64) / 2; }
__host__ __device__ __forceinline__ int perm32(int rho) { const int n = rho >> 4, i = rho & 15; return 8 * (i >> 2) + 4 * n + (i & 3); }

struct Unit { int pm, pn, z, w; };

__device__ __forceinline__ void static_tile(int L, int nM, int nN, int& pm, int& pn, int wgm = WGM) {
    const int nwg = nM * nN;
    int wgid = L; { const int q = nwg / NXCD, r = nwg % NXCD, xcd = wgid % NXCD, off = wgid / NXCD; wgid = (xcd < r ? xcd * (q + 1) : r * (q + 1) + (xcd - r) * q) + off; }
    const int nig = wgm * nN, gid = wgid / nig, fm = gid * wgm, gsz = (nM - fm) < wgm ? (nM - fm) : wgm;
    pm = fm + ((wgid % nig) % gsz); pn = (wgid % nig) / gsz;
}

template <class Epi, class Prob, bool HALFW = false>
__device__ __forceinline__ void gemm_phase(LAS unsigned char* lds, const Prob& S, const Epi& E, int wave) {
    int tid_ = wave * 64 + lane_id(); asm volatile("" : "+v"(tid_));
    const int tid = tid_, wid = wave, lane = tid & 63, wr = wid >> 2, wc = wid & 3, fr = lane & 15, fq = lane >> 4;
    const int K = S.K, nt = K / BK, lda = S.lda, ldb = S.ldb;
    unsigned voffA[2], voffB[2];
#pragma unroll
    for (int i = 0; i < 2; ++i) { int R, C; stage_rc(tid * 16 + i * 8192, R, C); const int Rb = Epi::PERM ? ((R & ~31) + perm32(R & 31)) : R;
        voffA[i] = (unsigned)(R * lda + C) * 2u; voffB[i] = (unsigned)(Rb * ldb + C) * 2u; }
    const size_t kstep = (size_t)(BK * 2);
    const size_t hsA = (size_t)HALF * lda * 2, hsB = (size_t)HALF * ldb * 2;
    const unsigned ldsw = (unsigned)wid * 1024u;
    const int aoff = lds_byte(wr * 64 + fr, fq * 8), boff = lds_byte(wc * 32 + fr, fq * 8);
#define PG8_SA(b, h) (((b) * 2 + (h)) * HTB)
#define PG8_SB(b, h) ((4 + (b) * 2 + (h)) * HTB)
#define PG8_STAGE(bufoff, gbase, voff) do { _Pragma("unroll") for (int _i = 0; _i < 2; ++_i) \
        __builtin_amdgcn_global_load_lds((const unsigned*)((const char*)(gbase) + (voff)[_i]), (LAS unsigned*)(lds + (bufoff) + ldsw + _i * 8192), 16, 0, 0); } while (0)
#define PG8_LDA(dst, b, h) do { _Pragma("unroll") for (int m = 0; m < 4; ++m) _Pragma("unroll") for (int k = 0; k < 2; ++k) dst[m][k] = *(const LAS bf16x8*)(lds + PG8_SA(b, h) + aoff + m * 2048 + k * 1024); } while (0)
#define PG8_LDB(dst, b, h) do { _Pragma("unroll") for (int n = 0; n < 2; ++n) _Pragma("unroll") for (int k = 0; k < 2; ++k) dst[n][k] = *(const LAS bf16x8*)(lds + PG8_SB(b, h) + boff + n * 2048 + k * 1024); } while (0)
#define PG8_MMA(ai, bj, At, Bt) do { __builtin_amdgcn_s_setprio(1); _Pragma("unroll") for (int m = 0; m < 4; ++m) _Pragma("unroll") for (int n = 0; n < 2; ++n) _Pragma("unroll") for (int k = 0; k < 2; ++k) \
        acc[ai][bj][m][n] = __builtin_amdgcn_mfma_f32_16x16x32_bf16(Bt[n][k], At[m][k], acc[ai][bj][m][n], 0, 0, 0); __builtin_amdgcn_s_setprio(0); } while (0)
#define PG8_WAIT_V(n) asm volatile("s_waitcnt vmcnt(" #n ")" ::: "memory")
#define PG8_WAIT_L(n) asm volatile("s_waitcnt lgkmcnt(" #n ")" ::: "memory")
#define PG8_BAR __builtin_amdgcn_s_barrier()
#define PG8_SCHED __builtin_amdgcn_sched_barrier(0)
    Unit cur, nxt; int ui = 0;
    if (!S.next(0, cur)) return;
    f32x4 acc[2][2][4][2];
#pragma unroll
    for (int a = 0; a < 2; ++a)
#pragma unroll
        for (int b = 0; b < 2; ++b)
#pragma unroll
            for (int m = 0; m < 4; ++m)
#pragma unroll
                for (int n = 0; n < 2; ++n) acc[a][b][m][n] = (f32x4){0.f, 0.f, 0.f, 0.f};
    bf16x8 At[4][2], B0[2][2], B1[2][2];
    const char* cA = S.a_ptr(cur); const char* cB = S.b_ptr(cur);
    if constexpr (HALFW) {
    PG8_STAGE(PG8_SB(0, 0), cB, voffB); PG8_STAGE(PG8_SA(0, 0), cA, voffA); PG8_STAGE(PG8_SA(0, 1), cA + hsA, voffA);
    if (wr == 1) PG8_BAR;
    PG8_WAIT_V(2); PG8_BAR;
    PG8_STAGE(PG8_SB(1, 0), cB + kstep, voffB); PG8_STAGE(PG8_SA(1, 0), cA + kstep, voffA);
    PG8_WAIT_V(4); PG8_BAR;
    } else if constexpr (PG8_SP2) {
    PG8_STAGE(PG8_SB(0, 0), cB, voffB); PG8_STAGE(PG8_SB(0, 1), cB + hsB, voffB); PG8_STAGE(PG8_SA(0, 0), cA, voffA); PG8_STAGE(PG8_SA(0, 1), cA + hsA, voffA);
    if (wr == 1) PG8_BAR;
    PG8_WAIT_V(2); PG8_BAR;
    PG8_STAGE(PG8_SB(1, 0), cB + kstep, voffB); PG8_STAGE(PG8_SA(1, 0), cA + kstep, voffA); PG8_STAGE(PG8_SB(1, 1), cB + hsB + kstep, voffB);
    PG8_WAIT_V(6); PG8_BAR;
    } else {
    PG8_STAGE(PG8_SB(0, 0), cB, voffB); PG8_STAGE(PG8_SA(0, 0), cA, voffA); PG8_STAGE(PG8_SB(0, 1), cB + hsB, voffB); PG8_STAGE(PG8_SA(0, 1), cA + hsA, voffA);
    if (wr == 1) PG8_BAR;
    PG8_WAIT_V(4); PG8_BAR;
    PG8_STAGE(PG8_SB(1, 0), cB + kstep, voffB); PG8_STAGE(PG8_SA(1, 0), cA + kstep, voffA); PG8_STAGE(PG8_SB(1, 1), cB + hsB + kstep, voffB);
    PG8_WAIT_V(6); PG8_BAR;
    }
    for (;;) {
        const bool has_next = S.next(ui + 1, nxt);
        const char* nA = has_next ? S.a_ptr(nxt) : cA; const char* nB = has_next ? S.b_ptr(nxt) : cB;
        for (int t = 0; t < nt; t += 2) {
            const bool last = (t == nt - 2);
            const char* a1 = cA + (size_t)(t + 1) * kstep;
            const char* a2 = last ? nA : cA + (size_t)(t + 2) * kstep; const char* b2 = last ? nB : cB + (size_t)(t + 2) * kstep;
            const char* a3 = a2 + kstep; const char* b3 = b2 + kstep;
            if constexpr (HALFW) {
            PG8_LDB(B0, 0, 0); PG8_SCHED; PG8_LDA(At, 0, 0); PG8_STAGE(PG8_SA(1, 1), a1 + hsA, voffA);
            PG8_WAIT_V(6); PG8_WAIT_L(0); PG8_BAR; PG8_MMA(0, 0, At, B0); PG8_BAR; PG8_SCHED;
            PG8_LDA(At, 0, 1); PG8_STAGE(PG8_SB(0, 0), b2, voffB); PG8_STAGE(PG8_SA(0, 0), a2, voffA);
            PG8_WAIT_V(6); PG8_WAIT_L(0); PG8_BAR; PG8_MMA(1, 0, At, B0); PG8_BAR; PG8_SCHED;
            PG8_LDB(B0, 1, 0); PG8_SCHED; PG8_LDA(At, 1, 0); PG8_STAGE(PG8_SA(0, 1), a2 + hsA, voffA);
            PG8_WAIT_V(6); PG8_WAIT_L(0); PG8_BAR; PG8_MMA(0, 0, At, B0); PG8_BAR; PG8_SCHED;
            PG8_LDA(At, 1, 1); PG8_STAGE(PG8_SB(1, 0), b3, voffB); PG8_STAGE(PG8_SA(1, 0), a3, voffA);
            PG8_WAIT_V(6); PG8_WAIT_L(0); PG8_BAR; PG8_MMA(1, 0, At, B0); PG8_BAR; PG8_SCHED;
            } else if constexpr (PG8_SP2) {
            PG8_LDB(B0, 0, 0); PG8_LDB(B1, 0, 1); PG8_SCHED; PG8_LDA(At, 0, 0); PG8_STAGE(PG8_SA(1, 1), a1 + hsA, voffA);
            PG8_WAIT_V(8); PG8_WAIT_L(0); PG8_BAR; PG8_MMA(0, 0, At, B0); PG8_MMA(0, 1, At, B1); PG8_BAR; PG8_SCHED;
            PG8_LDA(At, 0, 1); PG8_STAGE(PG8_SB(0, 0), b2, voffB); PG8_STAGE(PG8_SB(0, 1), b2 + hsB, voffB); PG8_STAGE(PG8_SA(0, 0), a2, voffA);
            PG8_WAIT_V(8); PG8_WAIT_L(0); PG8_BAR; PG8_MMA(1, 0, At, B0); PG8_MMA(1, 1, At, B1); PG8_BAR; PG8_SCHED;
            PG8_LDB(B0, 1, 0); PG8_LDB(B1, 1, 1); PG8_SCHED; PG8_LDA(At, 1, 0); PG8_STAGE(PG8_SA(0, 1), a2 + hsA, voffA);
            PG8_WAIT_V(8); PG8_WAIT_L(0); PG8_BAR; PG8_MMA(0, 0, At, B0); PG8_MMA(0, 1, At, B1); PG8_BAR; PG8_SCHED;
            PG8_LDA(At, 1, 1); PG8_STAGE(PG8_SB(1, 0), b3, voffB); PG8_STAGE(PG8_SB(1, 1), b3 + hsB, voffB); PG8_STAGE(PG8_SA(1, 0), a3, voffA);
            PG8_WAIT_V(8); PG8_WAIT_L(0); PG8_BAR; PG8_MMA(1, 0, At, B0); PG8_MMA(1, 1, At, B1); PG8_BAR; PG8_SCHED;
            } else {
            PG8_LDB(B0, 0, 0); PG8_SCHED; PG8_LDA(At, 0, 0); PG8_STAGE(PG8_SA(1, 1), a1 + hsA, voffA);
            PG8_WAIT_L(8); PG8_BAR; PG8_WAIT_L(0); PG8_MMA(0, 0, At, B0); PG8_BAR; PG8_SCHED;
            PG8_LDB(B1, 0, 1); PG8_STAGE(PG8_SB(0, 0), b2, voffB);
            PG8_BAR; PG8_WAIT_L(0); PG8_MMA(0, 1, At, B1); PG8_BAR;
            PG8_LDA(At, 0, 1); PG8_STAGE(PG8_SA(0, 0), a2, voffA);
            PG8_BAR; PG8_WAIT_L(0); PG8_MMA(1, 0, At, B0); PG8_BAR; PG8_SCHED;
            PG8_STAGE(PG8_SB(0, 1), b2 + hsB, voffB);
            PG8_WAIT_V(6); PG8_BAR; PG8_MMA(1, 1, At, B1); PG8_BAR;
            PG8_LDB(B0, 1, 0); PG8_SCHED; PG8_LDA(At, 1, 0); PG8_STAGE(PG8_SA(0, 1), a2 + hsA, voffA);
            PG8_WAIT_L(8); PG8_BAR; PG8_WAIT_L(0); PG8_MMA(0, 0, At, B0); PG8_BAR; PG8_SCHED;
            PG8_LDB(B1, 1, 1); PG8_STAGE(PG8_SB(1, 0), b3, voffB);
            PG8_BAR; PG8_WAIT_L(0); PG8_MMA(0, 1, At, B1); PG8_BAR;
            PG8_LDA(At, 1, 1); PG8_STAGE(PG8_SA(1, 0), a3, voffA);
            PG8_BAR; PG8_WAIT_L(0); PG8_MMA(1, 0, At, B0); PG8_BAR; PG8_SCHED;
            PG8_STAGE(PG8_SB(1, 1), b3 + hsB, voffB);
            PG8_WAIT_V(6); PG8_BAR; PG8_MMA(1, 1, At, B1); PG8_BAR;
            }
        }
        if (wr == 0) PG8_BAR;
        E(acc, cur, wr, wc, fr, fq);
        if (!has_next) break;
#pragma unroll
        for (int a = 0; a < 2; ++a)
#pragma unroll
            for (int b = 0; b < 2; ++b)
#pragma unroll
                for (int m = 0; m < 4; ++m)
#pragma unroll
                    for (int n = 0; n < 2; ++n) acc[a][b][m][n] = (f32x4){0.f, 0.f, 0.f, 0.f};
        cur = nxt; cA = nA; cB = nB; ++ui;
        if (wr == 1) PG8_BAR;
    }
    PG8_WAIT_V(0);
    PG8_BAR;
#undef PG8_SA
#undef PG8_SB
#undef PG8_STAGE
#undef PG8_LDA
#undef PG8_LDB
#undef PG8_MMA
#undef PG8_WAIT_V
#undef PG8_WAIT_L
#undef PG8_BAR
#undef PG8_SCHED
}
}
using pg8::Unit;

__device__ __forceinline__ float gelu_tanh(float x) {
    const float u = x * (0.7978845608028654f + 0.035677408136300125f * x * x);
    const float e = __builtin_amdgcn_exp2f(u * -2.8853900817779268f);
    return x * __builtin_amdgcn_rcpf(1.0f + e);
}

struct ProbMain {
    int K, lda, ldb; const bf16_t* A; const bf16_t* Bt; int nM, nN, G, c; int wgm = 8;
    __device__ __forceinline__ bool next(int i, Unit& u) const { const int L = i * G + c; if (L >= nM * nN) return false; int pm, pn; pg8::static_tile(L, nM, nN, pm, pn, wgm); u.pm = pm; u.pn = pn; u.z = 0; u.w = 0; return true; }
    __device__ __forceinline__ const char* a_ptr(const Unit& u) const { return (const char*)A + (size_t)u.pm * 256 * lda * 2; }
    __device__ __forceinline__ const char* b_ptr(const Unit& u) const { return (const char*)Bt + (size_t)u.pn * 256 * ldb * 2; }
};
struct ProbMainFix {
    ProbMain P; int K = P.K, lda = P.lda, ldb = P.ldb;
    __device__ __forceinline__ bool next(int i, Unit& u) const { return P.next(i, u); }
    __device__ __forceinline__ const char* a_ptr(const Unit& u) const { return (const char*)P.A + (size_t)(u.pm & PROBE_FIX_AMASK) * 256 * lda * 2; }
    __device__ __forceinline__ const char* b_ptr(const Unit& u) const { return (const char*)P.Bt + (size_t)(u.pn & PROBE_FIX_BMASK) * 256 * ldb * 2; }
};
struct ProbP1 {
    int K, lda, ldb; const unsigned char* ws; int G, c;
    static constexpr int NMAIN = (MT / 256) * (NIN / 256), NMEMU = 64;
    __device__ __forceinline__ bool next(int i, Unit& u) const {
        const int L = i * G + c; if (L >= NMAIN + 2 * NMEMU) return false;
        int pm, pn, z;
        if (L < NMAIN) { pg8::static_tile(L, MT / 256, NIN / 256, pm, pn); z = 0; }
        else { const int r = L - NMAIN; z = 1 + r / NMEMU; const int q = r % NMEMU; pm = q >> 3; pn = q & 7; }
        u.pm = pm; u.pn = pn; u.z = z; u.w = 0; return true; }
    __device__ __forceinline__ const char* a_ptr(const Unit& u) const { return (const char*)ws + (u.z == 0 ? WS_XB : WS_MEMB) + (size_t)u.pm * 256 * 2048 * 2; }
    __device__ __forceinline__ const char* b_ptr(const Unit& u) const { return (const char*)ws + (u.z == 0 ? WS_WIN : (u.z == 1 ? WS_WMK : WS_WMV)) + (size_t)u.pn * 256 * 2048 * 2; }
};
struct EpiP1 {
    static constexpr bool PERM = true;
    bf16_t *QB, *KB, *VB, *UB, *GB, *KS, *VS, *MKB, *MVB; float* out; unsigned* ctl; LAS float* xch;
    __device__ __forceinline__ void operator()(f32x4 (&acc)[2][2][4][2], const Unit& u, int wr, int wc, int fr, int fq) const {
        const int rowb = u.pm * 256 + wr * 64 + fr, cl = wc * 32 + 8 * fq;
        if (u.z == 0) {
            const int seg = u.pn >> 2; const bool samp = u.pm >= (MP / 256);
            if (seg <= 1) {
                unsigned* N2 = ctl + (seg == 0 ? CW_QN2 : CW_KN2);
#pragma unroll
                for (int ai = 0; ai < 2; ++ai)
#pragma unroll
                    for (int m = 0; m < 4; ++m)
#pragma unroll
                        for (int bj = 0; bj < 2; ++bj) { const f32x4 v0 = acc[ai][bj][m][0], v1 = acc[ai][bj][m][1];
                            float ss = (v0[0] * v0[0] + v0[1] * v0[1]) + (v0[2] * v0[2] + v0[3] * v0[3]) + (v1[0] * v1[0] + v1[1] * v1[1]) + (v1[2] * v1[2] + v1[3] * v1[3]);
                            ss += __shfl_xor(ss, 16); ss += __shfl_xor(ss, 32);
                            if (fq == 0) xch[((ai * 128 + wr * 64 + m * 16 + fr) * 2 + bj) * 4 + wc] = ss; }
                LDS_WAIT(); __builtin_amdgcn_s_barrier(); asm volatile("" ::: "memory");
                { const int w8 = wr * 4 + wc, t = w8 * 64 + fq * 16 + fr;
                  const f32x4 p4 = *(const LAS f32x4*)(xch + t * 4); float ss = (p4[0] + p4[1]) + (p4[2] + p4[3]);
                  ss = fmaxf(ss, __shfl_xor(ss, 2)); ss = fmaxf(ss, __shfl_xor(ss, 4)); ss = fmaxf(ss, __shfl_xor(ss, 8)); ss = fmaxf(ss, __shfl_xor(ss, 16)); ss = fmaxf(ss, __shfl_xor(ss, 32));
                  if (fq == 0 && fr < 2) { const int head = (u.pn & 3) * 2 + fr; const int idx = samp ? 64 + ((u.pm - MP / 256) * 8 + w8) * 8 + head : (u.pm >> 4) * 8 + head;
                      atomicMax(N2 + idx * 4, __float_as_uint(ss)); } }
            }
#pragma unroll
            for (int ai = 0; ai < 2; ++ai)
#pragma unroll
                for (int m = 0; m < 4; ++m) { const int row = rowb + ai * 128 + m * 16;
#pragma unroll
                    for (int bj = 0; bj < 2; ++bj) { const int c = (u.pn & 3) * 256 + bj * 128 + cl; f32x4 v0 = acc[ai][bj][m][0], v1 = acc[ai][bj][m][1];
                        if (seg >= 3) {
#pragma unroll
                            for (int e = 0; e < 4; ++e) { v0[e] = gelu_tanh(v0[e]); v1[e] = gelu_tanh(v1[e]); } }
                        u32x4 w; w.x = cvt_pk_bf16(v0[0], v0[1]); w.y = cvt_pk_bf16(v0[2], v0[3]); w.z = cvt_pk_bf16(v1[0], v1[1]); w.w = cvt_pk_bf16(v1[2], v1[3]);
                        const size_t o1 = (size_t)row * 1024 + c;
                        if (seg == 0) *(u32x4*)(QB + o1) = w;
                        else if (seg == 3) *(u32x4*)(UB + o1) = w;
                        else if (seg == 4) *(u32x4*)(GB + o1) = w;
                        else {
                            bf16_t* const B16 = seg == 1 ? KB : VB; *(u32x4*)(B16 + o1) = w;
                            if (samp) { float* fo = out + (seg == 1 ? O_FKS : O_FVS) + (size_t)(row - MP) * 1024 + c; *(f32x4*)fo = v0; *(f32x4*)(fo + 4) = v1;
                                const int rs = row - MP, bs = rs >> 5, t = rs & 31; bf16_t* const S16 = seg == 1 ? KS : VS;
                                *(u32x4*)(S16 + ((size_t)bs * SKS + PAST + t) * 1024 + c) = w; }
                        } } }
        } else {
#pragma unroll
            for (int ai = 0; ai < 2; ++ai)
#pragma unroll
                for (int m = 0; m < 4; ++m) { const int row = rowb + ai * 128 + m * 16;
#pragma unroll
                    for (int bj = 0; bj < 2; ++bj) { const int c = u.pn * 256 + bj * 128 + cl; const f32x4 v0 = acc[ai][bj][m][0], v1 = acc[ai][bj][m][1];
                        float* fo = out + (u.z == 1 ? O_MKP : O_MVP) + (size_t)row * 2048 + c; *(f32x4*)fo = v0; *(f32x4*)(fo + 4) = v1;
                        u32x4 w; w.x = cvt_pk_bf16(v0[0], v0[1]); w.y = cvt_pk_bf16(v0[2], v0[3]); w.z = cvt_pk_bf16(v1[0], v1[1]); w.w = cvt_pk_bf16(v1[2], v1[3]);
                        *(u32x4*)((u.z == 1 ? MKB : MVB) + (size_t)row * 2048 + c) = w;
                    } }
        }
    }
};
struct ProbPiece {
    int K, lda, ldb; const bf16_t* A; const bf16_t* Bt; int S, nN, G, c;
    __device__ __forceinline__ bool next(int i, Unit& u) const { const int L = i * G + c; if (L >= 2 * nN * S) return false; const int un = L / S, kp = L - un * S; u.pm = MP / 256 + un / nN; u.pn = un % nN; u.z = kp; u.w = 0; return true; }
    __device__ __forceinline__ const char* a_ptr(const Unit& u) const { return (const char*)A + ((size_t)u.pm * 256 * lda + (size_t)u.z * K) * 2; }
    __device__ __forceinline__ const char* b_ptr(const Unit& u) const { return (const char*)Bt + ((size_t)u.pn * 256 * ldb + (size_t)u.z * K) * 2; }
};
struct EpiSlab {
    static constexpr bool PERM = false;
    float* SLAB; int ldn;
    __device__ __forceinline__ void operator()(f32x4 (&acc)[2][2][4][2], const Unit& u, int wr, int wc, int fr, int fq) const {
        const int rowb = (u.pm - MP / 256) * 256 + wr * 64 + fr, colb = u.pn * 256 + wc * 32 + 4 * fq; float* sp = SLAB + (size_t)u.z * MS * ldn;
#pragma unroll
        for (int ai = 0; ai < 2; ++ai)
#pragma unroll
            for (int m = 0; m < 4; ++m) { float* op = sp + (size_t)(rowb + ai * 128 + m * 16) * ldn + colb;
#pragma unroll
                for (int bj = 0; bj < 2; ++bj)
#pragma unroll
                    for (int n = 0; n < 2; ++n) *(f32x4*)(op + bj * 128 + n * 16) = acc[ai][bj][m][n]; }
    }
};
template <int ACT> struct EpiBf16 {
    static constexpr bool PERM = true;
    bf16_t* O; int ldo;
    __device__ __forceinline__ void operator()(f32x4 (&acc)[2][2][4][2], const Unit& u, int wr, int wc, int fr, int fq) const {
        const int rowb = u.pm * 256 + wr * 64 + fr, colb = u.pn * 256 + wc * 32 + 8 * fq;
#pragma unroll
        for (int ai = 0; ai < 2; ++ai)
#pragma unroll
            for (int m = 0; m < 4; ++m) { bf16_t* op = O + (size_t)(rowb + ai * 128 + m * 16) * ldo + colb;
#pragma unroll
                for (int bj = 0; bj < 2; ++bj) { f32x4 v0 = acc[ai][bj][m][0], v1 = acc[ai][bj][m][1];
                    if (ACT == 1) {
#pragma unroll
                        for (int e = 0; e < 4; ++e) { const float a = fmaxf(v0[e], 0.f), b = fmaxf(v1[e], 0.f); v0[e] = a * a; v1[e] = b * b; } }
                    u32x4 w; w.x = cvt_pk_bf16(v0[0], v0[1]); w.y = cvt_pk_bf16(v0[2], v0[3]); w.z = cvt_pk_bf16(v1[0], v1[1]); w.w = cvt_pk_bf16(v1[2], v1[3]);
                    *(u32x4*)(op + bj * 128) = w; } }
    }
};
__device__ __forceinline__ void row_stats8(const float* STAT, int rowb, int fq, float (&mu)[2][4], float (&rs)[2][4]) {
    f32x4 st[2][4];
#pragma unroll
    for (int ai = 0; ai < 2; ++ai)
#pragma unroll
        for (int m = 0; m < 4; ++m) st[ai][m] = *(const f32x4*)(STAT + (size_t)(rowb + ai * 128 + m * 16) * 16 + 4 * fq);
#pragma unroll
    for (int ai = 0; ai < 2; ++ai)
#pragma unroll
        for (int m = 0; m < 4; ++m) { float s = st[ai][m][0] + st[ai][m][2], q = st[ai][m][1] + st[ai][m][3];
            s += __shfl_xor(s, 16); q += __shfl_xor(q, 16); s += __shfl_xor(s, 32); q += __shfl_xor(q, 32);
            const float mean = s * (1.0f / DM); mu[ai][m] = mean; rs[ai][m] = 1.0f / sqrtf(fmaxf(q * (1.0f / DM) - mean * mean, 0.f) + LN_EPS); }
}
template <bool FIRST, bool WRITE_S> struct EpiResLn {
    static constexpr bool PERM = false;
    const float* res; bf16_t* XLB; const float* STATi; float* STATo; const float* g; const float* b; LAS float* xch;
    struct RBuf { f32x4 f[4]; u32x2 h[4]; f32x4 st; };
    __device__ __forceinline__ void load_res(RBuf& r, int row, int colb, int fq) const {
#pragma unroll
        for (int bj = 0; bj < 2; ++bj)
#pragma unroll
            for (int n = 0; n < 2; ++n) { const int c = colb + bj * 128 + n * 16;
                if (FIRST) r.f[bj * 2 + n] = *(const f32x4*)(res + (size_t)row * DM + c); else r.h[bj * 2 + n] = *(const u32x2*)(XLB + (size_t)row * DM + c); }
        if (!FIRST) r.st = *(const f32x4*)(STATi + (size_t)row * 16 + 4 * fq);
    }
    __device__ __forceinline__ void operator()(f32x4 (&acc)[2][2][4][2], const Unit& u, int wr, int wc, int fr, int fq) const {
        const int rowb = u.pm * 256 + wr * 64 + fr, colb = u.pn * 256 + wc * 32 + 4 * fq;
        f32x4 gv[2][2], bv[2][2];
        RBuf rb[2]; load_res(rb[0], rowb, colb, fq);
        if (!FIRST) {
#pragma unroll
            for (int bj = 0; bj < 2; ++bj)
#pragma unroll
                for (int n = 0; n < 2; ++n) { gv[bj][n] = *(const f32x4*)(g + colb + bj * 128 + n * 16); bv[bj][n] = *(const f32x4*)(b + colb + bj * 128 + n * 16); } }
#pragma unroll
        for (int ai = 0; ai < 2; ++ai)
#pragma unroll
            for (int m = 0; m < 4; ++m) { const int idx = ai * 4 + m, row = rowb + ai * 128 + m * 16, lr = ai * 128 + wr * 64 + m * 16 + fr;
                if (idx + 1 < 8) load_res(rb[(idx + 1) & 1], rowb + ((idx + 1) >> 2) * 128 + ((idx + 1) & 3) * 16, colb, fq);
                const RBuf& rc = rb[idx & 1];
                float mu = 0.f, rs = 1.f;
                if (!FIRST) { float sq = rc.st[0] + rc.st[2], qq = rc.st[1] + rc.st[3];
                    sq += __shfl_xor(sq, 16); qq += __shfl_xor(qq, 16); sq += __shfl_xor(sq, 32); qq += __shfl_xor(qq, 32);
                    mu = sq * (1.0f / DM); rs = 1.0f / sqrtf(fmaxf(qq * (1.0f / DM) - mu * mu, 0.f) + LN_EPS); }
                bf16_t* xp = XLB + (size_t)row * DM; float s = 0.f, ss = 0.f;
#pragma unroll
                for (int bj = 0; bj < 2; ++bj)
#pragma unroll
                    for (int n = 0; n < 2; ++n) { const int c = colb + bj * 128 + n * 16; f32x4 x;
                        if (FIRST) x = rc.f[bj * 2 + n];
                        else { const u32x2 w = rc.h[bj * 2 + n]; x = (f32x4){__uint_as_float(w.x << 16), __uint_as_float(w.x & 0xffff0000u), __uint_as_float(w.y << 16), __uint_as_float(w.y & 0xffff0000u)};
                            x = (x - mu) * rs * gv[bj][n] + bv[bj][n]; }
                        const f32x4 y = x * ALPHA + acc[ai][bj][m][n];
                        u32x2 w; w.x = cvt_pk_bf16(y[0], y[1]); w.y = cvt_pk_bf16(y[2], y[3]); *(u32x2*)(xp + c) = w;
                        if (WRITE_S) { s += (y[0] + y[1]) + (y[2] + y[3]); ss += (y[0] * y[0] + y[1] * y[1]) + (y[2] * y[2] + y[3] * y[3]); } }
                if (WRITE_S) { s += __shfl_xor(s, 16); s += __shfl_xor(s, 32); ss += __shfl_xor(ss, 16); ss += __shfl_xor(ss, 32);
                    if (fq == 0) *(LAS f32x2*)(xch + (lr * 4 + wc) * 2) = (f32x2){s, ss}; } }
        if (WRITE_S) {
            LDS_WAIT(); __builtin_amdgcn_s_barrier(); asm volatile("" ::: "memory");
            const int t = (wr * 4 + wc) * 64 + fq * 16 + fr;
            if (t < 256) { const f32x4 a = *(const LAS f32x4*)(xch + t * 8), c = *(const LAS f32x4*)(xch + t * 8 + 4);
                *(f32x2*)(STATo + (size_t)(u.pm * 256 + t) * 16 + u.pn * 2) = (f32x2){(a[0] + a[2]) + (c[0] + c[2]), (a[1] + a[3]) + (c[1] + c[3])}; }
        }
    }
};
template <int ACT, bool HALFW = false> struct EpiLnBf16 {
    static constexpr bool PERM = true;
    bf16_t* O; int ldo; const float* STAT; const float* cs; const float* bw;
    __device__ __forceinline__ void operator()(f32x4 (&acc)[2][2][4][2], const Unit& u, int wr, int wc, int fr, int fq) const {
        constexpr int NBJ = HALFW ? 1 : 2;
        const int rowb = u.pm * 256 + wr * 64 + fr, colb = u.pn * 256 + (HALFW ? u.w * 128 : 0) + wc * 32 + 8 * fq;
        f32x4 c0[2], c1[2], w0[2], w1[2];
#pragma unroll
        for (int bj = 0; bj < NBJ; ++bj) { c0[bj] = *(const f32x4*)(cs + colb + bj * 128); c1[bj] = *(const f32x4*)(cs + colb + bj * 128 + 4); w0[bj] = *(const f32x4*)(bw + colb + bj * 128); w1[bj] = *(const f32x4*)(bw + colb + bj * 128 + 4); }
        float mu8[2][4], rs8[2][4]; row_stats8(STAT, rowb, fq, mu8, rs8);
#pragma unroll
        for (int ai = 0; ai < 2; ++ai)
#pragma unroll
            for (int m = 0; m < 4; ++m) { const int row = rowb + ai * 128 + m * 16; const float rs = rs8[ai][m], t = -rs * mu8[ai][m];
                bf16_t* op = O + (size_t)row * ldo + colb;
#pragma unroll
                for (int bj = 0; bj < NBJ; ++bj) { f32x4 v0 = acc[ai][bj][m][0] * rs + (c0[bj] * t + w0[bj]), v1 = acc[ai][bj][m][1] * rs + (c1[bj] * t + w1[bj]);
                    if (ACT == 1) {
#pragma unroll
                        for (int e = 0; e < 4; ++e) { const float a = fmaxf(v0[e], 0.f), b = fmaxf(v1[e], 0.f); v0[e] = a * a; v1[e] = b * b; } }
                    u32x4 w; w.x = cvt_pk_bf16(v0[0], v0[1]); w.y = cvt_pk_bf16(v0[2], v0[3]); w.z = cvt_pk_bf16(v1[0], v1[1]); w.w = cvt_pk_bf16(v1[2], v1[3]);
                    *(u32x4*)(op + bj * 128) = w; } }
    }
};
constexpr int NQSU = 32;
struct ProbM {
    int K, lda, ldb; const unsigned char* ws; int G, c;
    __device__ __forceinline__ bool next(int i, Unit& u) const { if (c < NQSU) return false; const int L = i * (G - NQSU) + (c - NQSU); if (L >= 256) return false; u.pm = L >> 3; u.pn = L & 7; u.z = 0; u.w = 0; return true; }
    __device__ __forceinline__ const char* a_ptr(const Unit& u) const { return (const char*)ws + WS_MKB + ((size_t)(u.pm >> 2) * 256 * 2048 + (u.pm & 3) * 512) * 2; }
    __device__ __forceinline__ const char* b_ptr(const Unit& u) const { return (const char*)ws + WS_WMQN + ((size_t)u.pn * 256 * 2048 + (u.pm & 3) * 512) * 2; }
};
struct ProbVW {
    int K, lda, ldb; const unsigned char* ws; int G, c;
    __device__ __forceinline__ bool next(int i, Unit& u) const { if (c < NQSU) return false; const int L = i * (G - NQSU) + (c - NQSU); if (L >= 256) return false; u.pm = L >> 2; u.pn = L & 3; u.z = 0; u.w = 0; return true; }
    __device__ __forceinline__ const char* a_ptr(const Unit& u) const { return (const char*)ws + WS_WMO + ((size_t)(u.pm & 7) * 256 * 2048 + u.pn * 512) * 2; }
    __device__ __forceinline__ const char* b_ptr(const Unit& u) const { return (const char*)ws + WS_MVB + ((size_t)(u.pm >> 3) * 256 * 2048 + u.pn * 512) * 2; }
};
struct ProbQs {
    int K, lda, ldb; const unsigned char* ws; int G, c;
    __device__ __forceinline__ bool next(int i, Unit& u) const { if (i > 0 || c >= NQSU) return false; u.pm = MP / 256 + (c >> 4); u.pn = (c >> 1) & 7; u.z = 0; u.w = c & 1; return true; }
    __device__ __forceinline__ const char* a_ptr(const Unit& u) const { return (const char*)ws + WS_XLB + (size_t)u.pm * 256 * 2048 * 2; }
    __device__ __forceinline__ const char* b_ptr(const Unit& u) const { return (const char*)ws + WS_WMQ + ((size_t)u.pn * 256 + u.w * 128) * 2048 * 2; }
};
struct ProbS2 {
    int K, lda, ldb; const unsigned char* ws; int G, c;
    __device__ __forceinline__ bool next(int i, Unit& u) const { const int L = i * G + c; if (L >= NB * 16 * MH) return false; const int b = L >> 6, r = L & 63; u.pm = b * SEQ + (r >> 2) * 256; u.pn = r & 3; u.z = 256; u.w = b; return true; }
    __device__ __forceinline__ const char* a_ptr(const Unit& u) const { return (const char*)ws + WS_XLB + (size_t)u.pm * 2048 * 2; }
    __device__ __forceinline__ const char* b_ptr(const Unit& u) const { return (const char*)ws + WS_MT + ((size_t)u.w * 1024 + u.pn * 256) * 2048 * 2; }
};
struct ProbO {
    int K, lda, ldb; const unsigned char* ws; int G, c;
    __device__ __forceinline__ bool next(int i, Unit& u) const { const int L = i * G + c; if (L >= NB * 16 * 8) return false; int pm, pn; pg8::static_tile(L, NB * 16, 8, pm, pn); u.pm = pm; u.pn = pn; u.z = 0; u.w = 0; return true; }
    __device__ __forceinline__ const char* a_ptr(const Unit& u) const { return (const char*)ws + WS_PB + (size_t)u.pm * 256 * 1024 * 2; }
    __device__ __forceinline__ const char* b_ptr(const Unit& u) const { return (const char*)ws + WS_VWT + ((size_t)(u.pm >> 4) * 2048 + u.pn * 256) * 1024 * 2; }
};
struct ProbS {
    int K, lda, ldb; const unsigned char* ws; int G, c;
    static constexpr int NPU = 0, NSU = NBS * MH;
    __device__ __forceinline__ bool next(int i, Unit& u) const {
        const int L = i * G + c; if (L >= NPU + NSU) return false;
        int pm, pn, z, w;
        if (L < NPU) { const int b = L >> 6, r = L & 63; pm = b * SEQ + (r >> 2) * 256; pn = r & 3; z = 256; w = b; }
        else { const int r = L - NPU, bs = r >> 2; pm = MP + bs * TS; pn = r & 3; z = TS; w = 8 + bs; }
        u.pm = pm; u.pn = pn; u.z = z; u.w = w; return true; }
    __device__ __forceinline__ const char* a_ptr(const Unit& u) const { return (const char*)ws + WS_QM + ((size_t)u.pm * 2048 + u.pn * 512) * 2; }
    __device__ __forceinline__ const char* b_ptr(const Unit& u) const { return (const char*)ws + (u.w < 8 ? WS_MKB + (size_t)u.w * 256 * 2048 * 2 : WS_CMK + (size_t)(u.w - 8) * 256 * 2048 * 2) + (size_t)u.pn * 512 * 2; }
};
template <bool FOLD> struct EpiSm {
    static constexpr bool PERM = true;
    bf16_t* PB; LAS float* xch;
    const float* STAT; const float* csM;
    __device__ __forceinline__ void operator()(f32x4 (&acc)[2][2][4][2], const Unit& u, int wr, int wc, int fr, int fq) const {
        constexpr float SC = MEM_SCALE * LOG2E;
        LAS float* xmax = xch; LAS float* xsum = xch + 1024;
        if (FOLD) {
            const float* cp = csM + u.w * 1024 + u.pn * 256 + wc * 32 + 8 * fq; f32x4 c0[2], c1[2], w0[2], w1[2];
#pragma unroll
            for (int bj = 0; bj < 2; ++bj) { c0[bj] = *(const f32x4*)(cp + bj * 128); c1[bj] = *(const f32x4*)(cp + bj * 128 + 4); w0[bj] = *(const f32x4*)(cp + 8192 + bj * 128); w1[bj] = *(const f32x4*)(cp + 8192 + bj * 128 + 4); }
            float mu8[2][4], rs8[2][4]; row_stats8(STAT, u.pm + wr * 64 + fr, fq, mu8, rs8);
#pragma unroll
            for (int ai = 0; ai < 2; ++ai)
#pragma unroll
                for (int m = 0; m < 4; ++m) { const float rs = rs8[ai][m], t = -rs * mu8[ai][m];
#pragma unroll
                    for (int bj = 0; bj < 2; ++bj) { acc[ai][bj][m][0] = acc[ai][bj][m][0] * rs + (c0[bj] * t + w0[bj]); acc[ai][bj][m][1] = acc[ai][bj][m][1] * rs + (c1[bj] * t + w1[bj]); } }
        }
#pragma unroll
        for (int ai = 0; ai < 2; ++ai)
#pragma unroll
            for (int m = 0; m < 4; ++m) { float mx = -3.0e38f;
#pragma unroll
                for (int bj = 0; bj < 2; ++bj)
#pragma unroll
                    for (int n = 0; n < 2; ++n) { f32x4 v = acc[ai][bj][m][n] * SC; acc[ai][bj][m][n] = v; mx = fmaxf(fmaxf(mx, fmaxf(v[0], v[1])), fmaxf(v[2], v[3])); }
                mx = fmaxf(mx, __shfl_xor(mx, 16)); mx = fmaxf(mx, __shfl_xor(mx, 32));
                if (fq == 0) xmax[(ai * 128 + wr * 64 + m * 16 + fr) * 4 + wc] = mx; }
        LDS_WAIT(); __builtin_amdgcn_s_barrier(); asm volatile("" ::: "memory");
#pragma unroll
        for (int ai = 0; ai < 2; ++ai)
#pragma unroll
            for (int m = 0; m < 4; ++m) { const int lr = ai * 128 + wr * 64 + m * 16 + fr; const f32x4 mm = *(const LAS f32x4*)(xmax + lr * 4);
                const float M = fmaxf(fmaxf(mm[0], mm[1]), fmaxf(mm[2], mm[3])); float s = 0.f;
#pragma unroll
                for (int bj = 0; bj < 2; ++bj)
#pragma unroll
                    for (int n = 0; n < 2; ++n) { f32x4 v = acc[ai][bj][m][n];
#pragma unroll
                        for (int e = 0; e < 4; ++e) v[e] = __builtin_amdgcn_exp2f(v[e] - M);
                        acc[ai][bj][m][n] = v; s += (v[0] + v[1]) + (v[2] + v[3]); }
                s += __shfl_xor(s, 16); s += __shfl_xor(s, 32);
                if (fq == 0) xsum[lr * 4 + wc] = s; }
        LDS_WAIT(); __builtin_amdgcn_s_barrier(); asm volatile("" ::: "memory");
#pragma unroll
        for (int ai = 0; ai < 2; ++ai)
#pragma unroll
            for (int m = 0; m < 4; ++m) { const int lr = ai * 128 + wr * 64 + m * 16 + fr; const f32x4 ss = *(const LAS f32x4*)(xsum + lr * 4);
                const float inv = 1.0f / ((ss[0] + ss[1]) + (ss[2] + ss[3]));
                if (lr < u.z) { bf16_t* op = PB + (size_t)(u.pm + lr) * 1024 + u.pn * 256 + wc * 32 + 8 * fq;
#pragma unroll
                    for (int bj = 0; bj < 2; ++bj) { const f32x4 v0 = acc[ai][bj][m][0] * inv, v1 = acc[ai][bj][m][1] * inv;
                        u32x4 w; w.x = cvt_pk_bf16(v0[0], v0[1]); w.y = cvt_pk_bf16(v0[2], v0[3]); w.z = cvt_pk_bf16(v1[0], v1[1]); w.w = cvt_pk_bf16(v1[2], v1[3]);
                        *(u32x4*)(op + bj * 128) = w; } } }
    }
};
struct ProbPV {
    int K, lda, ldb; const unsigned char* ws; int G, c;
    static constexpr int NPU = 0, NSU = NBS * MH * 2;
    __device__ __forceinline__ bool next(int i, Unit& u) const {
        const int L = i * G + c; if (L >= NPU + NSU) return false;
        int pm, pn, z, w;
        if (L < NPU) { const int b = L >> 7, r = L & 127; pm = b * SEQ + (r >> 3) * 256; pn = r & 7; z = 256; w = b; }
        else { const int r = L - NPU, bs = r >> 3; pm = MP + bs * TS; pn = r & 7; z = TS; w = 8 + bs; }
        u.pm = pm; u.pn = pn; u.z = z; u.w = w; return true; }
    __device__ __forceinline__ const char* a_ptr(const Unit& u) const { return (const char*)ws + WS_PB + ((size_t)u.pm * 1024 + (u.pn >> 1) * 256) * 2; }
    __device__ __forceinline__ const char* b_ptr(const Unit& u) const { return (const char*)ws + (WS_CMVT + (size_t)(u.w - 8) * 2048 * 256 * 2) + (size_t)u.pn * 256 * 256 * 2; }
};
struct EpiPV {
    static constexpr bool PERM = true;
    bf16_t* OM;
    __device__ __forceinline__ void operator()(f32x4 (&acc)[2][2][4][2], const Unit& u, int wr, int wc, int fr, int fq) const {
#pragma unroll
        for (int ai = 0; ai < 2; ++ai)
#pragma unroll
            for (int m = 0; m < 4; ++m) { const int lr = ai * 128 + wr * 64 + m * 16 + fr;
                if (lr < u.z) { bf16_t* op = OM + (size_t)(u.pm + lr) * 2048 + u.pn * 256 + wc * 32 + 8 * fq;
#pragma unroll
                    for (int bj = 0; bj < 2; ++bj) { const f32x4 v0 = acc[ai][bj][m][0], v1 = acc[ai][bj][m][1];
                        u32x4 w; w.x = cvt_pk_bf16(v0[0], v0[1]); w.y = cvt_pk_bf16(v0[2], v0[3]); w.z = cvt_pk_bf16(v1[0], v1[1]); w.w = cvt_pk_bf16(v1[2], v1[3]);
                        *(u32x4*)(op + bj * 128) = w; } } }
    }
};

namespace fox {
using bf16 = __hip_bfloat16;
constexpr int D = 128, LDQ = 1024, LDO = 2048;
constexpr int NW = 8, QBLK = 32, KVBLK = 64, QB = NW * QBLK;
constexpr int SHM_V = KVBLK * D * 2, SHM_K = KVBLK * D * 2;
constexpr int LDS_BIAS = 2 * SHM_V + 2 * SHM_K + NW * 64 * 4;
constexpr int LDS_JLO = LDS_BIAS + 2 * 256;
constexpr int LDS_BYTES = LDS_JLO + 32;
constexpr float SCALE = FOX_SCALE;
constexpr float THR = 8.f;
constexpr unsigned WBIG = 1u << 30;

#define KSWZ(row, colB) ((row) * 256 + ((colB) ^ (((row) & 7) << 4)))
#define SBAR() __builtin_amdgcn_sched_barrier(0)
__device__ __forceinline__ int v_st(int k, int c) { const int kk = (k & ~0xC) | ((k & 4) << 1) | ((k & 8) >> 1); return ((kk >> 3) * 4 + (c >> 5)) * 512 + ((kk & 7) * 32 + (c & 31)) * 2; }
__device__ __forceinline__ int v_rd_base(int lane) { return ((lane & 3) << 3) | (((lane >> 2) & 3) << 6) | (((lane >> 4) & 1) << 5) | (((lane >> 5) & 1) << 8); }
constexpr int v_rd_off(int d0, int ks, int half) { return d0 * 512 + ks * 4096 + half * 2048; }
__device__ __forceinline__ int crow(int r, int hi) { return (r & 3) + 8 * (r >> 2) + 4 * hi; }
__device__ __forceinline__ unsigned cvtpk(float lo, float hi) { unsigned r; asm volatile("v_cvt_pk_bf16_f32 %0, %1, %2" : "=v"(r) : "v"(lo), "v"(hi)); return r; }
__device__ __forceinline__ bf16x8 load8(const bf16* p) { return *reinterpret_cast<const bf16x8*>(p); }
__device__ __forceinline__ void mask_tile(f32x16& p0, f32x16& p1, int dq, unsigned W) {
    const float NEG = -__builtin_inff();
#pragma unroll
    for (int r = 0; r < 16; ++r) {
        const int c = (r & 3) + 8 * (r >> 2);
        if ((unsigned)(dq - c) >= W) p0[r] = NEG;
        if ((unsigned)(dq - c - 32) >= W) p1[r] = NEG;
    }
}
__device__ __forceinline__ void partialSM(f32x16& p0, f32x16& p1, float& m_reg, float& mn, float& alpha) {
    float pmax = p0[0];
#pragma unroll
    for (int r = 1; r < 16; ++r) pmax = fmaxf(pmax, p0[r]);
#pragma unroll
    for (int r = 0; r < 16; ++r) pmax = fmaxf(pmax, p1[r]);
    { auto rr = __builtin_amdgcn_permlane32_swap(__float_as_uint(pmax), __float_as_uint(pmax), false, false);
      pmax = fmaxf(__uint_as_float(rr[0]), __uint_as_float(rr[1])); }
    constexpr float C2 = 1.4426950408889634f * SCALE;
    if (__builtin_expect(__all((pmax - m_reg) * SCALE <= THR), 1)) { mn = m_reg; alpha = 1.f; }
    else { mn = fmaxf(m_reg, pmax); alpha = __builtin_amdgcn_exp2f((m_reg - mn) * C2); m_reg = mn; }
    const float mnL = -mn * C2;
#pragma unroll
    for (int r = 0; r < 16; ++r) p0[r] = fmaf(p0[r], C2, mnL);
#pragma unroll
    for (int r = 0; r < 16; ++r) p1[r] = fmaf(p1[r], C2, mnL);
#pragma unroll
    for (int r = 0; r < 16; ++r) p0[r] = __builtin_amdgcn_exp2f(p0[r]);
}
__device__ __forceinline__ void finishSM(f32x16& p0, f32x16& p1, float alpha, float& l_reg, bf16x8& pa0, bf16x8& pa1, bf16x8& pa2, bf16x8& pa3) {
#pragma unroll
    for (int r = 0; r < 16; ++r) p1[r] = __builtin_amdgcn_exp2f(p1[r]);
    float ps = 0;
#pragma unroll
    for (int r = 0; r < 16; ++r) ps += p0[r];
#pragma unroll
    for (int r = 0; r < 16; ++r) ps += p1[r];
    { auto rr = __builtin_amdgcn_permlane32_swap(__float_as_uint(ps), __float_as_uint(ps), false, false);
      ps = __uint_as_float(rr[0]) + __uint_as_float(rr[1]); }
    l_reg = l_reg * alpha + ps;
#define PK4(P, B_, OUT) do { unsigned a0 = cvtpk(P[B_+0], P[B_+1]), a1 = cvtpk(P[B_+2], P[B_+3]);                          \
        unsigned b0 = cvtpk(P[B_+4], P[B_+5]), b1 = cvtpk(P[B_+6], P[B_+7]);                                             \
        auto r0 = __builtin_amdgcn_permlane32_swap(a0, b0, false, false); auto r1 = __builtin_amdgcn_permlane32_swap(a1, b1, false, false); \
        u32x4 w = {r0[0], r1[0], r0[1], r1[1]}; OUT = *reinterpret_cast<bf16x8*>(&w); } while (0)
    PK4(p0, 0, pa0); PK4(p0, 8, pa1); PK4(p1, 0, pa2); PK4(p1, 8, pa3);
#undef PK4
}
template <int KB>
__device__ __forceinline__ void qkt(f32x16& p0, f32x16& p1, const char* K_lds, const char* B_lds, int r32, int hi, const bf16x8* qr, bool act) {
    if (!act) { const float NEG = -__builtin_inff();
#pragma unroll
        for (int r = 0; r < 16; ++r) { p0[r] = NEG; p1[r] = NEG; } return; }
    { const float* bl = (const float*)(B_lds + KB * 256) + 4 * hi;
#pragma unroll
      for (int g = 0; g < 4; ++g) { const f32x4 q0 = *(const f32x4*)(bl + 8 * g), q1 = *(const f32x4*)(bl + 32 + 8 * g);
#pragma unroll
          for (int e = 0; e < 4; ++e) { p0[4 * g + e] = q0[e]; p1[4 * g + e] = q1[e]; } } }
    const char* kb[4];
#pragma unroll
    for (int dd = 0; dd < 4; ++dd) kb[dd] = K_lds + KB * SHM_K + KSWZ(r32, (dd * 16 + hi * 8) * 2);
#pragma unroll
    for (int d0 = 0; d0 < 8; ++d0) { const char* a = kb[d0 & 3] + (d0 >> 2) * 128;
        bf16x8 b0 = *reinterpret_cast<const bf16x8*>(a);
        bf16x8 b1 = *reinterpret_cast<const bf16x8*>(a + 32 * 256);
        p0 = __builtin_amdgcn_mfma_f32_32x32x16_bf16(b0, qr[d0], p0, 0, 0, 0);
        p1 = __builtin_amdgcn_mfma_f32_32x32x16_bf16(b1, qr[d0], p1, 0, 0, 0); }
}
template <int VB>
__device__ __forceinline__ void pv_tile(f32x16* o, int vb0, bf16x8 pa0, bf16x8 pa1, bf16x8 pa2, bf16x8 pa3, bool act) {
    if (!act) return;
#define TRRD(dst, off) asm volatile("ds_read_b64_tr_b16 %0, %1 offset:%2" : "=&v"(dst) : "v"(vb0), "i"(off) : "memory")
#define PV_D0(d0) do { s16x4 l0, l1, l2, l3, h0, h1, h2, h3; constexpr int b_ = VB * SHM_V + v_rd_off(d0, 0, 0); \
        TRRD(l0, b_); TRRD(h0, b_ + 2048); TRRD(l1, b_ + 4096); TRRD(h1, b_ + 6144); TRRD(l2, b_ + 8192); TRRD(h2, b_ + 10240); TRRD(l3, b_ + 12288); TRRD(h3, b_ + 14336); \
        asm volatile("s_waitcnt lgkmcnt(0)" ::: "memory"); SBAR();   \
        o[d0] = __builtin_amdgcn_mfma_f32_32x32x16_bf16(pa0, (bf16x8){l0[0], l0[1], l0[2], l0[3], h0[0], h0[1], h0[2], h0[3]}, o[d0], 0, 0, 0);   \
        o[d0] = __builtin_amdgcn_mfma_f32_32x32x16_bf16(pa1, (bf16x8){l1[0], l1[1], l1[2], l1[3], h1[0], h1[1], h1[2], h1[3]}, o[d0], 0, 0, 0);   \
        o[d0] = __builtin_amdgcn_mfma_f32_32x32x16_bf16(pa2, (bf16x8){l2[0], l2[1], l2[2], l2[3], h2[0], h2[1], h2[2], h2[3]}, o[d0], 0, 0, 0);   \
        o[d0] = __builtin_amdgcn_mfma_f32_32x32x16_bf16(pa3, (bf16x8){l3[0], l3[1], l3[2], l3[3], h3[0], h3[1], h3[2], h3[3]}, o[d0], 0, 0, 0); } while (0)
    PV_D0(0); PV_D0(1); PV_D0(2); PV_D0(3);
#undef PV_D0
#undef TRRD
}

__device__ __forceinline__ int fox_jlo(const float* KX, int P0, float bound, int lane) {
    const int nt0 = P0 >> 6;
    const float thr = KX[P0] - bound;
    const float xv = lane < nt0 ? KX[64 * lane + 63] : 3.0e38f;
    return (int)__builtin_popcountll(__ballot(xv <= thr));
}
struct BlockRef { const bf16* Q; const bf16* K; const bf16* V; bf16* O; const float* KX; int P0; int skv; int nvalid; int nidx; };
struct Seam { bf16x8 qr[8]; bf16x8 st_v0, st_v1, st_k0, st_k1; float st_b; };
#define ROW(p, k0, rr) ((p) + (size_t)((k0) + (rr)) * LDQ + sc)
#define VMW() asm volatile("s_waitcnt vmcnt(0)" ::: "memory")
#define VMWN(n) asm volatile("s_waitcnt vmcnt(%0)" :: "i"(n) : "memory")
#define SLOAD_K(Kp, Bp, k0) do { S.st_b = (Bp)[(k0) + lane]; S.st_k0 = load8(ROW(Kp, k0, sr)); S.st_k1 = load8(ROW(Kp, k0, 32 + sr)); } while (0)
#define SLOAD_V(Vp, k0) do { S.st_v0 = load8(ROW(Vp, k0, sr)); S.st_v1 = load8(ROW(Vp, k0, 32 + sr)); } while (0)
#define SLOAD_H(Kp, Vp, Bp, k0) do { SLOAD_K(Kp, Bp, k0); SLOAD_V(Vp, k0); } while (0)
#define SWRITE_HK(bf) do { if (wid == 0) ((float*)(B_lds + (bf) * 256))[lane] = S.st_b; *(bf16x8*)(K_lds + (bf) * SHM_K + kws) = S.st_k0; *(bf16x8*)(K_lds + (bf) * SHM_K + kws + 32 * 256) = S.st_k1; } while (0)
#define SWRITE_HV(bf) do { *(bf16x8*)(V_lds + (bf) * SHM_V + vst0) = S.st_v0; *(bf16x8*)(V_lds + (bf) * SHM_V + vst1) = S.st_v1; } while (0)
#define SWRITE_H(bf) do { SWRITE_HV(bf); SWRITE_HK(bf); } while (0)
__device__ __forceinline__ void prime(const BlockRef& cur, char* lds, Seam& S, int wave) {
    int tid_ = wave * 64 + lane_id(); asm volatile("" : "+v"(tid_));
    const int tid = tid_, wid = wave, lane = tid & 63, r32 = lane & 31, hi = lane >> 5;
    const int sr = tid >> 4, sc = (tid & 15) * 8, kws = KSWZ(sr, sc * 2); char* K_lds = lds + 2 * SHM_V; char* B_lds = lds + LDS_BIAS;
#pragma unroll
    for (int d0 = 0; d0 < 8; ++d0) S.qr[d0] = load8(cur.Q + (size_t)(wid * QBLK + r32) * LDQ + d0 * 16 + hi * 8);
    const int kb0 = __builtin_amdgcn_readfirstlane(((const int*)(lds + LDS_JLO))[0]) * KVBLK;
    SLOAD_H(cur.K, cur.V, cur.KX, kb0); VMW(); SWRITE_HK(0);
    __syncthreads();
}
template <class Gen>
__device__ __forceinline__ void block(const Gen& gen, int bi, int nblk, char* lds, Seam& S, int wave) {
    const BlockRef cur = gen(bi);
    int tid_ = wave * 64 + lane_id(); asm volatile("" : "+v"(tid_));
    const int tid = tid_, wid = wave, lane = tid & 63, r32 = lane & 31, hi = lane >> 5;
    const unsigned W = WBIG;
    const int j_lo = __builtin_amdgcn_readfirstlane(((const int*)(lds + LDS_JLO))[bi]);
    int j_hi = (cur.P0 + QB - 1) / KVBLK + 1; if (j_hi > cur.skv / KVBLK) j_hi = cur.skv / KVBLK;
    const int NT = j_hi - j_lo;
    const int qlo = cur.P0 + wid * QBLK, qm = qlo + r32 - 4 * hi;
    const bool won = wid * QBLK < cur.nvalid;
    char* V_lds = lds; char* K_lds = lds + 2 * SHM_V; char* B_lds = lds + LDS_BIAS;
    float* ws = (float*)(lds + 2 * SHM_V + 2 * SHM_K) + wid * 64; float* li_l = ws, * al_l = ws + 32;
    float m_reg = -1e30f, l_reg = 0; f32x16 o[4] = {};
    const int sr = tid >> 4, sc = (tid & 15) * 8, vst0 = v_st(sr, sc), vst1 = v_st(32 + sr, sc), kws = KSWZ(sr, sc * 2);
    const int vb0 = (int)(uintptr_t)V_lds + v_rd_base(lane);
    const bf16* Kh = cur.K; const bf16* Vh = cur.V; const float* Bh = cur.KX;
#define RESC(a) do { if (__any((a) < 1.f)) { if (hi == 0) al_l[r32] = (a); asm volatile("s_waitcnt lgkmcnt(0)" ::: "memory");              \
                     for (int d_ = 0; d_ < 4; ++d_) for (int r = 0; r < 16; ++r) o[d_][r] *= al_l[crow(r, hi)]; } } while (0)
#define KBASE(t) ((j_lo + (t)) * KVBLK)
#define ACT(t) (won && KBASE(t) <= qlo + QBLK - 1)
    const bool emit = cur.nvalid == QB;
#define OKP (gen.outp + O_FKP + (cur.K - (const bf16*)(gen.ws + WS_KB)))
#define OVP (OKP + (O_FVP - O_FKP))
#define F4LO(w_) (f32x4){__uint_as_float(((const u32x4&)(w_)).x << 16), __uint_as_float(((const u32x4&)(w_)).x & 0xffff0000u), __uint_as_float(((const u32x4&)(w_)).y << 16), __uint_as_float(((const u32x4&)(w_)).y & 0xffff0000u)}
#define F4HI(w_) (f32x4){__uint_as_float(((const u32x4&)(w_)).z << 16), __uint_as_float(((const u32x4&)(w_)).z & 0xffff0000u), __uint_as_float(((const u32x4&)(w_)).w << 16), __uint_as_float(((const u32x4&)(w_)).w & 0xffff0000u)}
#define EMIT_KV(t) do { if (emit && KBASE(t) >= cur.P0) { const size_t o0_ = (size_t)(KBASE(t) + sr) * LDQ + sc, o1_ = o0_ + (size_t)32 * LDQ;              \
        *(f32x4*)(OKP + o0_) = F4LO(S.st_k0); *(f32x4*)(OKP + o0_ + 4) = F4HI(S.st_k0); asm volatile("" ::: "memory"); *(f32x4*)(OKP + o1_) = F4LO(S.st_k1); *(f32x4*)(OKP + o1_ + 4) = F4HI(S.st_k1); asm volatile("" ::: "memory"); \
        *(f32x4*)(OVP + o0_) = F4LO(S.st_v0); *(f32x4*)(OVP + o0_ + 4) = F4HI(S.st_v0); asm volatile("" ::: "memory"); *(f32x4*)(OVP + o1_) = F4LO(S.st_v1); *(f32x4*)(OVP + o1_ + 4) = F4HI(S.st_v1); } } while (0)
#define MASKT(P0_, P1_, t) do { const int kb_ = KBASE(t); if (ACT(t) && (kb_ + KVBLK - 1 > qlo)) mask_tile(P0_, P1_, qm - kb_, W); } while (0)
    constexpr int NQL = 8;
#define SEAM_K0() do { VMWN(NQL); SWRITE_HK(0); SBAR(); } while (0)
    f32x16 pA0, pA1, pB0, pB1; float mnA, mnB, alA, alB; bf16x8 pa0, pa1, pa2, pa3;
    SWRITE_HV(0); SBAR();
    if (NT > 1) { SLOAD_H(Kh, Vh, Bh, KBASE(1)); }
    SBAR(); qkt<0>(pA0, pA1, K_lds, B_lds, r32, hi, S.qr, ACT(0));
    MASKT(pA0, pA1, 0); partialSM(pA0, pA1, m_reg, mnA, alA);
    if (NT > 1) { VMW(); SWRITE_H(1); EMIT_KV(1); }
    __syncthreads();
#define HALF_STEP(PX0, PX1, mnX, alX, PY0, PY1, alY, t, KB, VB, SB) do {                                                      \
        SBAR(); if ((t) + 1 < NT) { SLOAD_K(Kh, Bh, KBASE((t) + 1)); SBAR(); }            \
        qkt<KB>(PX0, PX1, K_lds, B_lds, r32, hi, S.qr, ACT(t));                                                                  \
        finishSM(PY0, PY1, alY, l_reg, pa0, pa1, pa2, pa3); SBAR();                                                           \
        if ((t) + 1 < NT) { SLOAD_V(Vh, KBASE((t) + 1)); SBAR(); }                                                             \
        pv_tile<VB>(o, vb0, pa0, pa1, pa2, pa3, ACT((t) - 1)); MASKT(PX0, PX1, (t)); partialSM(PX0, PX1, m_reg, mnX, alX);     \
        __syncthreads();                                                                                                      \
        if ((t) + 1 < NT) { VMW(); SWRITE_H(SB); EMIT_KV((t) + 1); }                                                          \
        RESC(alX); __syncthreads(); } while (0)
    for (int t = 1; t + 1 < NT; t += 2) {
        HALF_STEP(pB0, pB1, mnB, alB, pA0, pA1, alA, t, 1, 0, 0);
        HALF_STEP(pA0, pA1, mnA, alA, pB0, pB1, alB, t + 1, 0, 1, 1);
    }
    const bool even = (NT & 1) == 0;
    if (even) { SBAR(); qkt<1>(pB0, pB1, K_lds, B_lds, r32, hi, S.qr, ACT(NT - 1)); SBAR(); }
    const int bn = bi + 1 < nblk ? bi + 1 : bi; const BlockRef nxt = gen(bn);
    const int kbn = __builtin_amdgcn_readfirstlane(((const int*)(lds + LDS_JLO))[bn]) * KVBLK;
    SLOAD_H(nxt.K, nxt.V, nxt.KX, kbn); SBAR();
#pragma unroll
    for (int d0 = 0; d0 < 8; ++d0) S.qr[d0] = load8(nxt.Q + (size_t)(wid * QBLK + r32) * LDQ + d0 * 16 + hi * 8);
    SBAR();
    finishSM(pA0, pA1, alA, l_reg, pa0, pa1, pa2, pa3); SBAR();
    pv_tile<0>(o, vb0, pa0, pa1, pa2, pa3, ACT(even ? NT - 2 : NT - 1));
    if (even) { MASKT(pB0, pB1, NT - 1); partialSM(pB0, pB1, m_reg, mnB, alB); __syncthreads(); RESC(alB);
        finishSM(pB0, pB1, alB, l_reg, pa0, pa1, pa2, pa3); SBAR(); pv_tile<1>(o, vb0, pa0, pa1, pa2, pa3, ACT(NT - 1)); }
    SBAR(); SEAM_K0();
    if (hi == 0) li_l[r32] = l_reg; asm volatile("s_waitcnt lgkmcnt(0)" ::: "memory");
    float rli[16];
#pragma unroll
    for (int r = 0; r < 16; ++r) rli[r] = __builtin_amdgcn_rcpf(li_l[crow(r, hi)]);
    bf16* Ow = cur.O + (size_t)(wid * QBLK) * LDO;
    if (won) {
    int ln = lane; asm volatile("" : "+v"(ln));
    const int r32e = ln & 31, hie = ln >> 5;
#pragma unroll
    for (int r = 0; r < 16; ++r) { const int orow = crow(r, hie);
#pragma unroll
        for (int d0 = 0; d0 < 4; ++d0) { const float v = o[d0][r] * rli[r];
            const float vn = __shfl_xor(v, 1);
            if ((r32e & 1) == 0) *(unsigned*)(Ow + (size_t)orow * LDO + d0 * 32 + r32e) = cvtpk(v, vn); } }
    }
    if (emit && KBASE(0) >= cur.P0) {
        const size_t o0_ = (size_t)(KBASE(0) + sr) * LDQ + sc, o1_ = o0_ + (size_t)32 * LDQ;
        const u32x4 k0_ = *(const u32x4*)(cur.K + o0_), k1_ = *(const u32x4*)(cur.K + o1_), v0_ = *(const u32x4*)(cur.V + o0_), v1_ = *(const u32x4*)(cur.V + o1_);
        *(f32x4*)(OKP + o0_) = F4LO(k0_); *(f32x4*)(OKP + o0_ + 4) = F4HI(k0_); *(f32x4*)(OKP + o1_) = F4LO(k1_); *(f32x4*)(OKP + o1_ + 4) = F4HI(k1_);
        *(f32x4*)(OVP + o0_) = F4LO(v0_); *(f32x4*)(OVP + o0_ + 4) = F4HI(v0_); *(f32x4*)(OVP + o1_) = F4LO(v1_); *(f32x4*)(OVP + o1_ + 4) = F4HI(v1_);
    }
    __syncthreads();
#undef RESC
#undef KBASE
#undef ACT
#undef MASKT
#undef EMIT_KV
#undef OKP
#undef OVP
#undef F4LO
#undef F4HI
#undef SEAM_K0
#undef HALF_STEP
}
#undef ROW
#undef VMW
#undef VMWN
#undef SLOAD_H
#undef SLOAD_K
#undef SLOAD_V
#undef SWRITE_HK
#undef SWRITE_HV
#undef SWRITE_H
#undef KSWZ
#undef SBAR
}

struct Frame {
    LAS unsigned char* lds;
    int wave, vcu, G;
};
__device__ __forceinline__ float wave_sum(float v) {
#pragma unroll
    for (int o = 1; o < 64; o <<= 1) v += __shfl_xor(v, o);
    return v;
}
__device__ __forceinline__ unsigned pk2(float lo, float hi) { return cvt_pk_bf16(lo, hi); }

struct TItem { const float* W; bf16_t* WT; const float* gv; const float* bv; float* cs; float* bw; int ldw, K, k0, nsrc, ndst, fold; };
__device__ __forceinline__ void titem_load(const TItem& d, f32x4 (&tv)[8], int lane) {
#pragma unroll
    for (int i = 0; i < 8; ++i) tv[i] = *(const f32x4*)(d.W + (size_t)(d.k0 + 8 * i + (lane >> 3)) * d.ldw + d.nsrc + 4 * (lane & 7));
}
template <bool FOLD>
__device__ __forceinline__ void titem_finish(const TItem& d, const f32x4 (&tv)[8], LAS float* scr, int lane) {
#pragma unroll
    for (int i = 0; i < 8; ++i) { LAS float* p = scr + (8 * i + (lane >> 3)) * 33 + 4 * (lane & 7); p[0] = tv[i][0]; p[1] = tv[i][1]; p[2] = tv[i][2]; p[3] = tv[i][3]; }
    LDS_WAIT(); asm volatile("" ::: "memory");
    const int c = lane & 7; const int k0 = d.k0;
    f32x4 g0, g1, b0, b1;
    if (FOLD) { g0 = *(const f32x4*)(d.gv + k0 + 8 * c); g1 = *(const f32x4*)(d.gv + k0 + 8 * c + 4); b0 = *(const f32x4*)(d.bv + k0 + 8 * c); b1 = *(const f32x4*)(d.bv + k0 + 8 * c + 4); }
#pragma unroll
    for (int j = 0; j < 4; ++j) { const int n = (lane >> 3) + 8 * j; const LAS float* s = scr + (8 * c) * 33 + n;
        float w[8];
#pragma unroll
        for (int e = 0; e < 8; ++e) w[e] = s[e * 33];
        u32x4 o;
        if (FOLD) { o.x = pk2(w[0] * g0[0], w[1] * g0[1]); o.y = pk2(w[2] * g0[2], w[3] * g0[3]); o.z = pk2(w[4] * g1[0], w[5] * g1[1]); o.w = pk2(w[6] * g1[2], w[7] * g1[3]);
            float csum = 0.f, bsum = 0.f;
#pragma unroll
            for (int e = 0; e < 4; ++e) { csum += __uint_as_float(o[e] << 16) + __uint_as_float(o[e] & 0xffff0000u); }
            bsum = ((w[0] * b0[0] + w[1] * b0[1]) + (w[2] * b0[2] + w[3] * b0[3])) + ((w[4] * b1[0] + w[5] * b1[1]) + (w[6] * b1[2] + w[7] * b1[3]));
            csum += __shfl_xor(csum, 1); csum += __shfl_xor(csum, 2); csum += __shfl_xor(csum, 4); bsum += __shfl_xor(bsum, 1); bsum += __shfl_xor(bsum, 2); bsum += __shfl_xor(bsum, 4);
            if (c == 0) { atomicAdd(d.cs + d.ndst + n, csum); atomicAdd(d.bw + d.ndst + n, bsum); } }
        else { o.x = pk2(w[0], w[1]); o.y = pk2(w[2], w[3]); o.z = pk2(w[4], w[5]); o.w = pk2(w[6], w[7]); }
        *(GAS u32x4*)(d.WT + (size_t)(d.ndst + n) * d.K + k0 + 8 * c) = o; }
    LDS_WAIT(); asm volatile("" ::: "memory");
}
__device__ __forceinline__ void cvt_flat(const float* src, bf16_t* dst, size_t n, int bshift, size_t bstride, size_t gt, size_t NGT) {
    const size_t mask = ((size_t)1 << bshift) - 1;
    size_t e = gt * 8;
    for (; e + 3 * NGT * 8 < n; e += 4 * NGT * 8) {
        f32x4 a[4], b[4];
#pragma unroll
        for (int i = 0; i < 4; ++i) { a[i] = *(const f32x4*)(src + e + i * NGT * 8); b[i] = *(const f32x4*)(src + e + i * NGT * 8 + 4); }
#pragma unroll
        for (int i = 0; i < 4; ++i) { const size_t ee = e + i * NGT * 8; u32x4 w; w.x = pk2(a[i][0], a[i][1]); w.y = pk2(a[i][2], a[i][3]); w.z = pk2(b[i][0], b[i][1]); w.w = pk2(b[i][2], b[i][3]);
            *(u32x4*)(dst + (ee >> bshift) * bstride + (ee & mask)) = w; } }
    for (; e < n; e += NGT * 8) { const f32x4 a = *(const f32x4*)(src + e), b = *(const f32x4*)(src + e + 4);
        u32x4 w; w.x = pk2(a[0], a[1]); w.y = pk2(a[2], a[3]); w.z = pk2(b[0], b[1]); w.w = pk2(b[2], b[3]);
        *(u32x4*)(dst + (e >> bshift) * bstride + (e & mask)) = w; }
}
__device__ __forceinline__ float log_sigmoid_f(float y) { return y >= 0.f ? -log1pf(expf(-y)) : y - log1pf(expf(y)); }

__device__ __forceinline__ void ln_prompt(Frame& F, const bf16_t* XLB, float* R, const float* g, const float* b) {
    const int gw = F.vcu * NWAVES + F.wave, NGW = F.G * NWAVES;
    int lane_ = lane_id(); asm volatile("" : "+v"(lane_)); const int lane = lane_;
    f32x4 gg[8], bb[8];
#pragma unroll
    for (int j = 0; j < 8; ++j) { gg[j] = *(const f32x4*)(g + 256 * j + 4 * lane); bb[j] = *(const f32x4*)(b + 256 * j + 4 * lane); }
    for (int m = gw; m < MP; m += NGW) {
        const bf16_t* xp = XLB + (size_t)m * DM + 4 * lane; float* rp = R + (size_t)m * DM + 4 * lane; f32x4 v[8]; float s = 0.f;
#pragma unroll
        for (int j = 0; j < 8; ++j) { const u32x2 w = *(const u32x2*)(xp + 256 * j); v[j] = (f32x4){__uint_as_float(w.x << 16), __uint_as_float(w.x & 0xffff0000u), __uint_as_float(w.y << 16), __uint_as_float(w.y & 0xffff0000u)};
            s += (v[j][0] + v[j][1]) + (v[j][2] + v[j][3]); }
        const float mean = wave_sum(s) * (1.f / DM); float q = 0.f;
#pragma unroll
        for (int j = 0; j < 8; ++j) { v[j] = v[j] - mean; q += (v[j][0] * v[j][0] + v[j][1] * v[j][1]) + (v[j][2] * v[j][2] + v[j][3] * v[j][3]); }
        const float rstd = 1.0f / sqrtf(wave_sum(q) * (1.f / DM) + LN_EPS);
#pragma unroll
        for (int j = 0; j < 8; ++j) *(f32x4*)(rp + 256 * j) = v[j] * rstd * gg[j] + bb[j];
    }
}
template <int MODE>
__device__ __forceinline__ void sample_combine(Frame& F, float* R, bf16_t* XLB, float* STATo, const float* xs, const float* gp, const float* bp, const float* gf, const float* bf, const float* SLAB, int S) {
    const int gw = F.wave * F.G + F.vcu, NGW = F.G * NWAVES;
    int lane_ = lane_id(); asm volatile("" : "+v"(lane_)); const int lane = lane_;
    for (int ms = gw; ms < MS; ms += NGW) { const int m = MP + ms;
        float* rp = R + (size_t)m * DM + 4 * lane; const float* xp = (MODE == 1 ? xs + (size_t)ms * DM : R + (size_t)m * DM) + 4 * lane; f32x4 v[8];
#pragma unroll
        for (int j = 0; j < 8; ++j) v[j] = *(const f32x4*)(xp + 256 * j);
        if (MODE >= 2) { float s = 0.f;
#pragma unroll
            for (int j = 0; j < 8; ++j) s += (v[j][0] + v[j][1]) + (v[j][2] + v[j][3]);
            const float mean = wave_sum(s) * (1.f / DM); float q = 0.f;
#pragma unroll
            for (int j = 0; j < 8; ++j) { v[j] = v[j] - mean; q += (v[j][0] * v[j][0] + v[j][1] * v[j][1]) + (v[j][2] * v[j][2] + v[j][3] * v[j][3]); }
            const float rstd = 1.0f / sqrtf(wave_sum(q) * (1.f / DM) + LN_EPS);
#pragma unroll
            for (int j = 0; j < 8; ++j) v[j] = v[j] * rstd * *(const f32x4*)(gp + 256 * j + 4 * lane) + *(const f32x4*)(bp + 256 * j + 4 * lane); }
#pragma unroll
        for (int j = 0; j < 8; ++j) v[j] = v[j] * ALPHA;
#pragma unroll 1
        for (int kp = 0; kp < S; kp += 4) { const float* sp = SLAB + ((size_t)kp * MS + ms) * DM + 4 * lane; f32x4 t0[8], t1[8], t2[8], t3[8];
#pragma unroll
            for (int j = 0; j < 8; ++j) { t0[j] = *(const f32x4*)(sp + 256 * j); t1[j] = *(const f32x4*)(sp + (size_t)MS * DM + 256 * j); t2[j] = *(const f32x4*)(sp + (size_t)2 * MS * DM + 256 * j); t3[j] = *(const f32x4*)(sp + (size_t)3 * MS * DM + 256 * j); }
#pragma unroll
            for (int j = 0; j < 8; ++j) v[j] += (t0[j] + t1[j]) + (t2[j] + t3[j]); }
        if (MODE <= 2) { float s = 0.f, q = 0.f;
#pragma unroll
            for (int j = 0; j < 8; ++j) { *(f32x4*)(rp + 256 * j) = v[j]; u32x2 w; w.x = pk2(v[j][0], v[j][1]); w.y = pk2(v[j][2], v[j][3]); *(u32x2*)(XLB + (size_t)m * DM + 256 * j + 4 * lane) = w;
                s += (v[j][0] + v[j][1]) + (v[j][2] + v[j][3]); q += (v[j][0] * v[j][0] + v[j][1] * v[j][1]) + (v[j][2] * v[j][2] + v[j][3] * v[j][3]); }
            s = wave_sum(s); q = wave_sum(q);
            if (lane < 8) *(f32x2*)(STATo + (size_t)m * 16 + 2 * lane) = lane == 0 ? (f32x2){s, q} : (f32x2){0.f, 0.f};
        } else { float s = 0.f;
#pragma unroll
            for (int j = 0; j < 8; ++j) s += (v[j][0] + v[j][1]) + (v[j][2] + v[j][3]);
            const float mean = wave_sum(s) * (1.f / DM); float q = 0.f;
#pragma unroll
            for (int j = 0; j < 8; ++j) { v[j] = v[j] - mean; q += (v[j][0] * v[j][0] + v[j][1] * v[j][1]) + (v[j][2] * v[j][2] + v[j][3] * v[j][3]); }
            const float rstd = 1.0f / sqrtf(wave_sum(q) * (1.f / DM) + LN_EPS);
#pragma unroll
            for (int j = 0; j < 8; ++j) *(f32x4*)(rp + 256 * j) = v[j] * rstd * *(const f32x4*)(gf + 256 * j + 4 * lane) + *(const f32x4*)(bf + 256 * j + 4 * lane); }
    }
}

__device__ __forceinline__ void csm_rows(Frame& F, const bf16_t* MKB, const float* cs1, const float* bw1, float* csM) {
    const int gw = F.vcu * NWAVES + F.wave, NGW = F.G * NWAVES;
    int lane_ = lane_id(); asm volatile("" : "+v"(lane_)); const int lane = lane_;
    for (int r = gw; r < NB * NMEM; r += NGW) { const bf16_t* mp = MKB + (size_t)r * DM + lane * 32; float a = 0.f, c = 0.f;
#pragma unroll
        for (int q = 0; q < 4; ++q) { const u32x4 w = *(const u32x4*)(mp + 8 * q); const f32x4 c0 = *(const f32x4*)(cs1 + lane * 32 + 8 * q), c1 = *(const f32x4*)(cs1 + lane * 32 + 8 * q + 4), b0 = *(const f32x4*)(bw1 + lane * 32 + 8 * q), b1 = *(const f32x4*)(bw1 + lane * 32 + 8 * q + 4);
#pragma unroll
            for (int e = 0; e < 2; ++e) { const float x0 = __uint_as_float(w[e] << 16), x1 = __uint_as_float(w[e] & 0xffff0000u), x2 = __uint_as_float(w[2 + e] << 16), x3 = __uint_as_float(w[2 + e] & 0xffff0000u);
                a += x0 * c0[2 * e] + x1 * c0[2 * e + 1] + x2 * c1[2 * e] + x3 * c1[2 * e + 1]; c += x0 * b0[2 * e] + x1 * b0[2 * e + 1] + x2 * b1[2 * e] + x3 * b1[2 * e + 1]; } }
#pragma unroll
        for (int o = 1; o < 16; o <<= 1) { a += __shfl_xor(a, o); c += __shfl_xor(c, o); }
        if ((lane & 15) == 0) { const int b = r >> 8, key = r & 255, h = lane >> 4; csM[b * 1024 + h * 256 + key] = a; csM[8192 + b * 1024 + h * 256 + key] = c; }
    }
}
__device__ __forceinline__ void cvt_rowscale(const float* src, bf16_t* dst, const float* g, size_t n, size_t gt, size_t NGT) {
#pragma unroll 4
    for (size_t e = gt * 8; e < n; e += NGT * 8) { const f32x4 a = *(const f32x4*)(src + e), b = *(const f32x4*)(src + e + 4); const float gk = g[e >> 11];
        u32x4 w; w.x = pk2(a[0] * gk, a[1] * gk); w.y = pk2(a[2] * gk, a[3] * gk); w.z = pk2(b[0] * gk, b[1] * gk); w.w = pk2(b[2] * gk, b[3] * gk); *(u32x4*)(dst + e) = w; }
}

constexpr int SGU_TS = 576;
constexpr int SGU_WS = 272;
constexpr int SGU_WOFF = 128 * SGU_TS, SGU_SOFF = SGU_WOFF + 128 * SGU_WS;
template <int NROWS, class AP>
__device__ __forceinline__ void sgu_unit(Frame& F, unsigned char* ws, AP (*getp)(), int row0, float* gvs  , int g0 = 0, int g1 = 4  ) {
    constexpr int nrows = NROWS; constexpr bool FULL = NROWS == 128;
    const bf16_t* GB = (const bf16_t*)(ws + WS_GB);
    LAS unsigned char* tile = F.lds; LAS unsigned char* wtile = F.lds + SGU_WOFF; LAS float* stats = (LAS float*)(F.lds + SGU_SOFF);
    int tid_ = F.wave * 64 + lane_id(); asm volatile("" : "+v"(tid_));
    const int tid = tid_, lane = tid & 63, wid = F.wave, r32 = lane & 31, hi = lane >> 5;
    { const int r = tid >> 2, q4 = tid & 3; float s = 0.f, ss = 0.f;
      if (FULL || r < nrows) { const bf16_t* gp = GB + (size_t)(row0 + r) * GW + q4 * 256;
#pragma unroll 16
          for (int i = 0; i < 32; ++i) { const u32x4 a = *(const u32x4*)(gp + 8 * i);
#pragma unroll
              for (int e = 0; e < 4; ++e) { const float x0 = __uint_as_float(a[e] << 16), x1 = __uint_as_float(a[e] & 0xffff0000u); s += x0 + x1; ss = fmaf(x0, x0, ss); ss = fmaf(x1, x1, ss); } } }
      s += __shfl_xor(s, 1); ss += __shfl_xor(ss, 1); s += __shfl_xor(s, 2); ss += __shfl_xor(ss, 2);
      if ((FULL || r < nrows) && q4 == 0) { const float mean = s * (1.f / GW); const float var = fmaxf(ss * (1.f / GW) - mean * mean, 0.f); stats[2 * r] = mean; stats[2 * r + 1] = 1.0f / sqrtf(var + LN_EPS); } }
    LDS_WAIT(); __syncthreads();
    constexpr int nmb = nrows / 32;
#pragma unroll 1
    for (int g = g0; g < g1; ++g) {
        { const float* ln_g = getp()->in[10]; const float* ln_b = getp()->in[11]; const float* wsp = getp()->in[12];
          u32x4 av[8]; f32x4 wa[4][2];
#pragma unroll
          for (int k = 0; k < 8; ++k) { const int idx = tid + 512 * k, r = idx >> 5, ch = idx & 31; if (FULL || r < nrows) av[k] = *(const u32x4*)(GB + (size_t)(row0 + r) * GW + g * 256 + ch * 8); }
#pragma unroll
          for (int k = 0; k < 4; ++k) { const int idx = tid + 512 * k, t = idx >> 4, s0 = (idx & 15) * 8; if (FULL || t < nrows) { const float* wp = wsp + ((size_t)g * 128 + t) * 128 + s0; wa[k][0] = *(const f32x4*)wp; wa[k][1] = *(const f32x4*)(wp + 4); } }
#pragma unroll
          for (int k = 0; k < 8; ++k) { const int idx = tid + 512 * k, r = idx >> 5, ch = idx & 31;
            if (FULL || r < nrows) { const int col = g * 256 + ch * 8; const u32x4 a = av[k];
                const float mean = stats[2 * r], rstd = stats[2 * r + 1];
                const f32x4 g0 = *(const f32x4*)(ln_g + col), g1 = *(const f32x4*)(ln_g + col + 4), b0 = *(const f32x4*)(ln_b + col), b1 = *(const f32x4*)(ln_b + col + 4);
                f32x4 y0, y1;
#pragma unroll
                for (int e = 0; e < 2; ++e) { y0[2 * e] = (__uint_as_float(a[e] << 16) - mean) * rstd * g0[2 * e] + b0[2 * e]; y0[2 * e + 1] = (__uint_as_float(a[e] & 0xffff0000u) - mean) * rstd * g0[2 * e + 1] + b0[2 * e + 1];
                    y1[2 * e] = (__uint_as_float(a[2 + e] << 16) - mean) * rstd * g1[2 * e] + b1[2 * e]; y1[2 * e + 1] = (__uint_as_float(a[2 + e] & 0xffff0000u) - mean) * rstd * g1[2 * e + 1] + b1[2 * e + 1]; }
                if (gvs) { float* gp = gvs + (size_t)(row0 - MP + r) * GW + col; *(f32x4*)gp = y0; *(f32x4*)(gp + 4) = y1; }
                u32x4 w; w.x = pk2(y0[0], y0[1]); w.y = pk2(y0[2], y0[3]); w.z = pk2(y1[0], y1[1]); w.w = pk2(y1[2], y1[3]);
                *(LAS u32x4*)(tile + r * SGU_TS + ch * 16) = w; } }
#pragma unroll
          for (int k = 0; k < 4; ++k) { const int idx = tid + 512 * k, t = idx >> 4, s0 = (idx & 15) * 8;
            if (FULL || t < nrows) { const f32x4 a0 = wa[k][0], a1 = wa[k][1];
                u32x4 aw; aw.x = pk2(s0 + 0 <= t ? a0[0] : 0.f, s0 + 1 <= t ? a0[1] : 0.f); aw.y = pk2(s0 + 2 <= t ? a0[2] : 0.f, s0 + 3 <= t ? a0[3] : 0.f);
                aw.z = pk2(s0 + 4 <= t ? a1[0] : 0.f, s0 + 5 <= t ? a1[1] : 0.f); aw.w = pk2(s0 + 6 <= t ? a1[2] : 0.f, s0 + 7 <= t ? a1[3] : 0.f);
                *(LAS u32x4*)(wtile + t * SGU_WS + s0 * 2) = aw; } } }
        LDS_WAIT(); __syncthreads();
        u32x4 uvp[8];
#pragma unroll
        for (int k = 0; k < 8; ++k) { const int idx = tid + 512 * k, r = idx >> 5, ch = idx & 31; if (FULL || r < nrows) uvp[k] = *(const u32x4*)((const bf16_t*)(ws + WS_UB) + (size_t)(row0 + r) * GW + g * 256 + ch * 8); }
        const int i16 = lane & 15;
        const LAS unsigned char* bbase = tile + (8 * hi + (i16 >> 2)) * SGU_TS + (32 * wid + 16 * ((lane >> 4) & 1) + 4 * (i16 & 3)) * 2;
        f32x16 acc[4];
#pragma unroll
        for (int mb = 0; mb < 4; ++mb) { acc[mb] = f32x16{};
            if (mb < nmb) { const LAS unsigned char* abase = wtile + (32 * mb + r32) * SGU_WS + 16 * hi;
#pragma unroll
                for (int ks = 0; ks < 8; ++ks) { if (ks <= 2 * mb + 1) {
                    const bf16x8 af = *(const LAS bf16x8*)(abase + 32 * ks);
                    const s16x4 lo = __builtin_bit_cast(s16x4, __builtin_amdgcn_ds_read_tr16_b64_v4i16((LAS s16x4*)(bbase + 16 * ks * SGU_TS)));
                    const s16x4 hh = __builtin_bit_cast(s16x4, __builtin_amdgcn_ds_read_tr16_b64_v4i16((LAS s16x4*)(bbase + (16 * ks + 4) * SGU_TS)));
                    const bf16x8 bf = (bf16x8){lo[0], lo[1], lo[2], lo[3], hh[0], hh[1], hh[2], hh[3]};
                    acc[mb] = __builtin_amdgcn_mfma_f32_32x32x16_bf16(af, bf, acc[mb], 0, 0, 0); } } } }
        LDS_WAIT(); __syncthreads();
        const float* b_s = getp()->in[13];
#pragma unroll
        for (int mb = 0; mb < 4; ++mb) { if (mb < nmb) {
#pragma unroll
            for (int r = 0; r < 16; ++r) { const int t = 32 * mb + (r & 3) + 8 * (r >> 2) + 4 * hi;
                *(LAS unsigned short*)(tile + t * SGU_TS + (32 * wid + r32) * 2) = f2bf(acc[mb][r] + b_s[g * 128 + t]); } } }
        LDS_WAIT(); __syncthreads();
#pragma unroll
        for (int k = 0; k < 8; ++k) { const int idx = tid + 512 * k, r = idx >> 5, ch = idx & 31;
            if (FULL || r < nrows) { const int col = g * 256 + ch * 8; const u32x4 sv = *(const LAS u32x4*)(tile + r * SGU_TS + ch * 16);
                const u32x4 uv = uvp[k]; u32x4 w;
#pragma unroll
                for (int e = 0; e < 4; ++e) w[e] = pk2(__uint_as_float(sv[e] << 16) * __uint_as_float(uv[e] << 16), __uint_as_float(sv[e] & 0xffff0000u) * __uint_as_float(uv[e] & 0xffff0000u));
                *(u32x4*)((bf16_t*)(ws + WS_FOGO) + (size_t)(row0 + r) * DM + FW + col) = w; } }
        LDS_WAIT(); __syncthreads();
    }
}

struct Args { const float* in[27]; float* out; unsigned char* ws; int ph_lo, ph_hi; };
typedef const __attribute__((address_space(4))) Args* ArgsP;
__device__ __forceinline__ ArgsP get_args() { ArgsP p = (ArgsP)__builtin_amdgcn_kernarg_segment_ptr(); asm volatile("" : "+s"(p)); return p; }
enum { I_XP = 0, I_XS, I_MEM, I_CFK, I_CFV, I_CFL, I_CMK, I_CMV, I_WIN, I_BF, I_SLG, I_SLB, I_WS, I_BS, I_WOUT, I_L1G, I_L1B, I_WMQ, I_WMK, I_WMV, I_WMO, I_L2G, I_L2B, I_WUP, I_WDN, I_L3G, I_L3B };

constexpr int NORM_CHUNKS = NBS * 128, NORM_SPLIT = 1280;
__device__ __forceinline__ void cache_norms(const float* cfk, unsigned* kn, int c0, int c1, int gw, int NGW, int lane) {
    for (int c = c0 + gw; c < c1; c += NGW) { const int bs = c >> 7; const float* rp = cfk + ((size_t)bs * PAST + (size_t)(c & 127) * 32) * FW + lane * 16; float mx = 0.f;
#pragma unroll 8
        for (int r = 0; r < 32; ++r) { const f32x4 a = *(const f32x4*)(rp + (size_t)r * FW), b = *(const f32x4*)(rp + (size_t)r * FW + 4), c4 = *(const f32x4*)(rp + (size_t)r * FW + 8), d = *(const f32x4*)(rp + (size_t)r * FW + 12);
            float ss = ((a[0] * a[0] + a[1] * a[1]) + (a[2] * a[2] + a[3] * a[3])) + ((b[0] * b[0] + b[1] * b[1]) + (b[2] * b[2] + b[3] * b[3])) + ((c4[0] * c4[0] + c4[1] * c4[1]) + (c4[2] * c4[2] + c4[3] * c4[3])) + ((d[0] * d[0] + d[1] * d[1]) + (d[2] * d[2] + d[3] * d[3]));
            ss += __shfl_xor(ss, 1); ss += __shfl_xor(ss, 2); ss += __shfl_xor(ss, 4); mx = fmaxf(mx, ss); }
        if ((lane & 7) == 0) atomicMax(kn + bs * FH + (lane >> 3), __float_as_uint(mx)); }
}

__device__ __forceinline__ void p0_prologue(Frame& F, ArgsP Ap) {
    unsigned char* ws = Ap->ws;
    int tidp_ = F.wave * 64 + lane_id(); asm volatile("" : "+v"(tidp_)); const int tidp = tidp_;
    const int gw = F.vcu * NWAVES + F.wave, NGW = F.G * NWAVES, lane = tidp & 63;
    const size_t gt = (size_t)blockIdx.x * (NWAVES * 64) + tidp, NGT = (size_t)F.G * (NWAVES * 64);
    LAS float* wf = (LAS float*)F.lds;
    { const float* w_in = Ap->in[I_WIN];
#pragma unroll
      for (int k = tidp; k < DM; k += NWAVES * 64) { const float* wp = w_in + (size_t)k * INC + 3 * FW;
          const f32x4 a = *(const f32x4*)wp, b = *(const f32x4*)(wp + 4);
          wf[k] = a[0]; wf[DM + k] = a[1]; wf[2 * DM + k] = a[2]; wf[3 * DM + k] = a[3]; wf[4 * DM + k] = b[0]; wf[5 * DM + k] = b[1]; wf[6 * DM + k] = b[2]; wf[7 * DM + k] = b[3]; } }
    LDS_WAIT(); __syncthreads();
    { const float* xp = Ap->in[I_XP]; const float* xs = Ap->in[I_XS]; bf16_t* XB = (bf16_t*)(ws + WS_XB); const float bfv = Ap->in[I_BF][lane >> 3];
      f32x4 vn[8];
      if (gw < MT) { const float* xr = (gw < MP ? xp + (size_t)gw * DM : xs + (size_t)(gw - MP) * DM) + 4 * lane;
#pragma unroll
          for (int j = 0; j < 8; ++j) vn[j] = *(const f32x4*)(xr + 256 * j); }
#pragma unroll 1
      for (int m = gw; m < MT; m += NGW) {
          f32x4 v[8];
#pragma unroll
          for (int j = 0; j < 8; ++j) v[j] = vn[j];
          { const int m2 = m + NGW; if (m2 < MT) { const float* xr = (m2 < MP ? xp + (size_t)m2 * DM : xs + (size_t)(m2 - MP) * DM) + 4 * lane;
#pragma unroll
              for (int j = 0; j < 8; ++j) vn[j] = *(const f32x4*)(xr + 256 * j); } }
#pragma unroll
          for (int j = 0; j < 8; ++j) { u32x2 w; w.x = pk2(v[j][0], v[j][1]); w.y = pk2(v[j][2], v[j][3]); *(u32x2*)(XB + (size_t)m * DM + 256 * j + 4 * lane) = w; }
          float z[FH];
#pragma unroll
          for (int h = 0; h < FH; ++h) { float a = 0.f;
#pragma unroll
              for (int j = 0; j < 8; ++j) { const f32x4 w4 = *(const LAS f32x4*)(wf + h * DM + 256 * j + 4 * lane); a = fmaf(v[j][0], w4[0], a); a = fmaf(v[j][1], w4[1], a); a = fmaf(v[j][2], w4[2], a); a = fmaf(v[j][3], w4[3], a); }
              z[h] = a; }
          float y4[4], y2[2], zz;
          { const bool up = (lane & 32) != 0;
#pragma unroll
            for (int i = 0; i < 4; ++i) { const float keep = up ? z[4 + i] : z[i], give = up ? z[i] : z[4 + i]; y4[i] = keep + __shfl_xor(give, 32); } }
          { const bool up = (lane & 16) != 0;
#pragma unroll
            for (int i = 0; i < 2; ++i) { const float keep = up ? y4[2 + i] : y4[i], give = up ? y4[i] : y4[2 + i]; y2[i] = keep + __shfl_xor(give, 16); } }
          { const bool up = (lane & 8) != 0; const float keep = up ? y2[1] : y2[0], give = up ? y2[0] : y2[1]; zz = keep + __shfl_xor(give, 8); }
          zz += __shfl_xor(zz, 4); zz += __shfl_xor(zz, 2); zz += __shfl_xor(zz, 1);
          if ((lane & 7) == 0) { const int h = lane >> 3; const float lf = log_sigmoid_f(zz + bfv); Ap->out[(m < MP ? O_FLP + (size_t)m * FH : O_FLS + (size_t)(m - MP) * FH) + h] = lf; }
      } }
    __syncthreads();
    cvt_flat(Ap->in[I_MEM], (bf16_t*)(ws + WS_MEMB), (size_t)NB * NMEM * DM, 40, 0, gt, NGT);
    cvt_flat(Ap->in[I_CMK], (bf16_t*)(ws + WS_CMK), (size_t)NBS * NMEM * DM, 40, 0, gt, NGT);
    cvt_rowscale(Ap->in[I_WMQ], (bf16_t*)(ws + WS_WMQN), Ap->in[I_L1G], (size_t)DM * DM, gt, NGT);
    cache_norms(Ap->in[I_CFK], (unsigned*)(ws + WS_CTL) + CW_KN2C, 0, NORM_CHUNKS, gw, NGW, lane);
    for (size_t e = gt * 8; e < (size_t)NBS * 32 * FW; e += NGT * 8) { const size_t d = (e >> 15) * ((size_t)SKS * FW) + (size_t)(PAST + TS) * FW + (e & 32767);
        *(u32x4*)((bf16_t*)(ws + WS_KS) + d) = (u32x4){0u, 0u, 0u, 0u}; *(u32x4*)((bf16_t*)(ws + WS_VS) + d) = (u32x4){0u, 0u, 0u, 0u}; }
    LAS float* scr = (LAS float*)(F.lds + F.wave * 16384);
    {
        constexpr int I_IN = (DM / 64) * (NIN / 32), I_SQ = (DM / 64) * (DM / 32), I_UP = (DM / 64) * (DFF / 32), I_DN = (DFF / 64) * (DM / 32), I_CV = (NMEM / 64) * (DM / 32);
        constexpr int NITEMS = I_IN + 5 * I_SQ + I_UP + I_DN + NBS * I_CV;
        auto decode = [&](int it) -> TItem { TItem d; int r = it; d.gv = nullptr; d.bv = nullptr; d.cs = nullptr; d.bw = nullptr; d.fold = 0;
            if (r < I_UP) { const int nblk = DFF / 32, kb = r / nblk, n0 = 32 * (r % nblk); d.W = Ap->in[I_WUP]; d.WT = (bf16_t*)(ws + WS_WUP); d.ldw = DFF; d.K = DM; d.k0 = 64 * kb; d.nsrc = n0; d.ndst = n0;
                d.gv = Ap->in[I_L2G]; d.bv = Ap->in[I_L2B]; d.cs = (float*)(ws + WS_CTL) + CW_CS2; d.bw = (float*)(ws + WS_CTL) + CW_BW2; d.fold = 1; return d; } r -= I_UP;
            if (r < I_DN) { const int nblk = DM / 32, kb = r / nblk, n0 = 32 * (r % nblk); d.W = Ap->in[I_WDN]; d.WT = (bf16_t*)(ws + WS_WDN); d.ldw = DM; d.K = DFF; d.k0 = 64 * kb; d.nsrc = n0; d.ndst = n0; return d; } r -= I_DN;
            if (r < I_IN) { const int nblk = NIN / 32, kb = r / nblk, n0 = 32 * (r % nblk); d.W = Ap->in[I_WIN]; d.WT = (bf16_t*)(ws + WS_WIN); d.ldw = INC; d.K = DM; d.k0 = 64 * kb; d.nsrc = n0 + (n0 >= 3 * FW ? FH : 0); d.ndst = n0; return d; } r -= I_IN;
            if (r < I_SQ) { const int nblk = DM / 32, kb = r / nblk, n0 = 32 * (r % nblk); d.W = Ap->in[I_WMQ]; d.WT = (bf16_t*)(ws + WS_WMQ); d.ldw = DM; d.K = DM; d.k0 = 64 * kb; d.nsrc = n0; d.ndst = n0;
                d.gv = Ap->in[I_L1G]; d.bv = Ap->in[I_L1B]; d.cs = (float*)(ws + WS_CTL) + CW_CS1; d.bw = (float*)(ws + WS_CTL) + CW_BW1; d.fold = 1; return d; } r -= I_SQ;
            if (r < 4 * I_SQ) { const int wsel = r / I_SQ, q = r - wsel * I_SQ, nblk = DM / 32, kb = q / nblk, n0 = 32 * (q % nblk);
                d.W = Ap->in[wsel == 0 ? I_WOUT : wsel == 1 ? I_WMK : wsel == 2 ? I_WMV : I_WMO];
                d.WT = (bf16_t*)(ws + (wsel == 0 ? WS_WOUT : wsel == 1 ? WS_WMK : wsel == 2 ? WS_WMV : WS_WMO)); d.ldw = DM; d.K = DM; d.k0 = 64 * kb; d.nsrc = n0; d.ndst = n0; return d; } r -= 4 * I_SQ;
            { const int bs = r / I_CV, q = r - bs * I_CV, nblk = DM / 32, kb = q / nblk, n0 = 32 * (q % nblk);
              d.W = Ap->in[I_CMV] + (size_t)bs * NMEM * DM; d.WT = (bf16_t*)(ws + WS_CMVT) + (size_t)bs * DM * NMEM; d.ldw = DM; d.K = NMEM; d.k0 = 64 * kb; d.nsrc = n0; d.ndst = n0; return d; } };
        if (gw < NITEMS) {
            TItem cur = decode(gw); f32x4 tv[8]; titem_load(cur, tv, lane);
#pragma unroll 1
            for (int it = gw; it < NITEMS; it += NGW) { const bool more = it + NGW < NITEMS; TItem nxt = cur; f32x4 tn[8];
                if (more) { nxt = decode(it + NGW); titem_load(nxt, tn, lane); }
                if (cur.fold) titem_finish<true>(cur, tv, scr, lane); else titem_finish<false>(cur, tv, scr, lane);
                if (more) { cur = nxt;
#pragma unroll
                    for (int i = 0; i < 8; ++i) tv[i] = tn[i]; } }
        }
    }
}

__device__ __forceinline__ void cumsum_unit(Frame& F, int seq, ArgsP A) {
    LAS double* tot = (LAS double*)F.lds; LAS double* part = tot + 512; LAS double* pexc = part + 64;
    int tidc_ = F.wave * 64 + lane_id(); asm volatile("" : "+v"(tidc_)); const int tid = tidc_; const bool samp = seq >= NB * FH; const int s = samp ? seq - NB * FH : seq, bb = s >> 3, h = s & 7;
    const float* src = (samp ? A->in[I_CFL] + ((size_t)bb * PAST) * FH + h : A->out + O_FLP + ((size_t)bb * SEQ) * FH + h) + (size_t)(8 * tid) * FH;
    float* dst = samp ? (float*)(A->ws + WS_KXS) + (size_t)s * SKS : (float*)(A->ws + WS_KXP) + (size_t)s * SEQ;
    float x0 = src[0], x1 = src[FH], x2 = src[2 * FH], x3 = src[3 * FH], x4 = src[4 * FH], x5 = src[5 * FH], x6 = src[6 * FH], x7 = src[7 * FH];
    tot[tid] = (((double)x0 + (double)x1) + ((double)x2 + (double)x3)) + (((double)x4 + (double)x5) + ((double)x6 + (double)x7));
    LDS_WAIT(); __syncthreads();
    if (tid < 64) { double a = 0.0;
#pragma unroll 1
        for (int j = 0; j < 8; ++j) a += tot[8 * tid + j];
        part[tid] = a; }
    LDS_WAIT(); __syncthreads();
    if (tid == 0) { double a = 0.0;
#pragma unroll 8
        for (int j = 0; j < 64; ++j) { pexc[j] = a; a += part[j]; } pexc[64] = a; }
    LDS_WAIT(); __syncthreads();
    double c = pexc[tid >> 3];
#pragma unroll 1
    for (int j = 0; j < (tid & 7); ++j) c += tot[8 * (tid >> 3) + j];
    constexpr double INV = -1.0 / (double)FOX_SCALE;
    float* dp = dst + 8 * tid;
    c += (double)x0; dp[0] = (float)(c * INV); c += (double)x1; dp[1] = (float)(c * INV); c += (double)x2; dp[2] = (float)(c * INV); c += (double)x3; dp[3] = (float)(c * INV);
    c += (double)x4; dp[4] = (float)(c * INV); c += (double)x5; dp[5] = (float)(c * INV); c += (double)x6; dp[6] = (float)(c * INV); c += (double)x7; dp[7] = (float)(c * INV);
    if (samp && tid < 64) {
        LAS float* sv = (LAS float*)(pexc + 66);
        if (tid < TS) sv[tid] = (A->out + O_FLS + ((size_t)bb * TS) * FH + h)[(size_t)tid * FH];
        LDS_WAIT();
        if (tid < TS) { double c2 = pexc[64];
#pragma unroll 1
            for (int j = 0; j <= tid; ++j) c2 += (double)sv[j];
            dst[PAST + tid] = (float)(c2 * INV); }
        else dst[PAST + tid] = 0.f;
    }
    __syncthreads();
}

struct FoxGen {
    unsigned char* ws; int vcu; float* outp;
    __device__ __forceinline__ fox::BlockRef operator()(int i) const {
        fox::BlockRef br;
        if (i < 4) { const int item = vcu + 256 * (i >> 1), bh = item >> 3, x = item & 7, qb = (i & 1) ? 15 - x : x, b = bh >> 3, h = bh & 7;
            const size_t r0 = (size_t)b * SEQ + (size_t)qb * 256;
            br.Q = (const fox::bf16*)(ws + WS_QB) + r0 * FW + h * FD; br.K = (const fox::bf16*)(ws + WS_KB) + (size_t)b * SEQ * FW + h * FD; br.V = (const fox::bf16*)(ws + WS_VB) + (size_t)b * SEQ * FW + h * FD;
            br.O = (fox::bf16*)(ws + WS_FOGO) + r0 * DM + h * FD; br.KX = (const float*)(ws + WS_KXP) + (size_t)bh * SEQ; br.P0 = qb * 256; br.skv = SEQ; br.nvalid = 256; br.nidx = bh; }
        else { const int bs = vcu >> 3, h = vcu & 7; const size_t r0 = (size_t)MP + (size_t)bs * TS;
            br.Q = (const fox::bf16*)(ws + WS_QB) + r0 * FW + h * FD; br.K = (const fox::bf16*)(ws + WS_KS) + (size_t)bs * SKS * FW + h * FD; br.V = (const fox::bf16*)(ws + WS_VS) + (size_t)bs * SKS * FW + h * FD;
            br.O = (fox::bf16*)(ws + WS_FOGO) + r0 * DM + h * FD; br.KX = (const float*)(ws + WS_KXS) + (size_t)vcu * SKS; br.P0 = PAST; br.skv = SKS; br.nvalid = TS; br.nidx = 64 + vcu; }
        return br;
    }
};

constexpr int N_PHASES = 13;
__global__ void __launch_bounds__(NWAVES * 64, 2) fwd(Args args) {
    extern __shared__ __attribute__((aligned(16))) unsigned char lds[];
    Frame F;
    F.lds = (LAS unsigned char*)lds;
    F.wave = __builtin_amdgcn_readfirstlane((int)threadIdx.x >> 6);
    F.G = gridDim.x; { const int bx = blockIdx.x; F.vcu = (F.G % 8 == 0) ? (bx % 8) * (F.G / 8) + bx / 8 : bx; }
    unsigned char* ws;
#if MK_N_LAUNCHES == 1
    constexpr int lo = 0, hi = N_PHASES;
    { ArgsP a0 = get_args(); ws = a0->ws; }
#else
    int lo, hi;
    { ArgsP a0 = get_args(); ws = a0->ws; lo = a0->ph_lo; hi = a0->ph_hi; }
#endif
#define out (get_args()->out)
    for (int u = (int)threadIdx.x; u < (LDS_BYTES - LDSCTL_OFF) / 4; u += NWAVES * 64) ((LAS unsigned*)(F.lds + LDSCTL_OFF))[u] = 0u;
    __syncthreads();
    if (MK_N_LAUNCHES == 1) (void)xcd_barrier_post((unsigned*)((gu32*)(ws + WS_CTL) + CW_BAR), (volatile LAS unsigned*)(F.lds + MISC_OFF) + 8, threadIdx.x == 0);
#define GRID_BARRIER() do { XcdBarrier b_; b_.bar = (unsigned*)((gu32*)(ws + WS_CTL) + CW_BAR); b_.x = xb_xcc_id(); b_.st = (volatile LAS unsigned*)(F.lds + MISC_OFF) + 8; b_.G = (unsigned)F.G; b_.t0 = (F.wave == 0 && lane_id() == 0); xcd_barrier(b_); } while (0)
#ifndef PH_MASK
#define PH_MASK 0x1FFF
#endif
#define IN(k) (((PH_MASK >> (k)) & 1) && lo <= (k) && (k) < hi)
#define SEAM(k) do { if (IN(k) && IN((k) + 1)) GRID_BARRIER(); } while (0)
#ifndef PROBE_REPEAT
#define PROBE_REPEAT 0
#endif
#define R_ (out + O_YP)
#define WSB(off) ((bf16_t*)(ws + (off)))
    const int bx = (int)blockIdx.x;

    if (IN(0)) { p0_prologue(F, get_args()); }
#if (PROBE_REPEAT >> 0) & 1
    GRID_BARRIER(); if (IN(0)) { p0_prologue(F, get_args()); }
#endif
    SEAM(0);
    if (IN(1)) {
        if (F.vcu < NB * FH + NBS * FH) cumsum_unit(F, F.vcu, get_args());
        ProbP1 S{DM, DM, DM, ws, F.G, bx};
        EpiP1 E{WSB(WS_QB), WSB(WS_KB), WSB(WS_VB), WSB(WS_UB), WSB(WS_GB), WSB(WS_KS), WSB(WS_VS), (bf16_t*)(ws + WS_MKB), (bf16_t*)(ws + WS_MVB), out, (unsigned*)(ws + WS_CTL), (LAS float*)(F.lds + XCH_OFF)};
        pg8::gemm_phase<EpiP1, ProbP1>(F.lds, S, E, F.wave);
    }
#if (PROBE_REPEAT >> 1) & 1
    GRID_BARRIER();
    if (IN(1)) {
        if (F.vcu < NB * FH + NBS * FH) cumsum_unit(F, F.vcu, get_args());
        ProbP1 S{DM, DM, DM, ws, F.G, bx};
        EpiP1 E{WSB(WS_QB), WSB(WS_KB), WSB(WS_VB), WSB(WS_UB), WSB(WS_GB), WSB(WS_KS), WSB(WS_VS), (bf16_t*)(ws + WS_MKB), (bf16_t*)(ws + WS_MVB), out, (unsigned*)(ws + WS_CTL), (LAS float*)(F.lds + XCH_OFF)};
        pg8::gemm_phase<EpiP1, ProbP1>(F.lds, S, E, F.wave);
    }
#endif
    SEAM(1);
    if (IN(2)) {
#ifndef NO_FOX
        {
            const int nblk = F.vcu < NBS * FH ? 5 : 4;
            const FoxGen gen{ws, F.vcu, out};
            fox::Seam S;
            {
              const int ln = lane_id(); const float* nq = (const float*)(ws + WS_CTL) + CW_QN2; const float* nk = (const float*)(ws + WS_CTL) + CW_KN2; const float* nc = (const float*)(ws + WS_CTL) + CW_KN2C;
#pragma unroll
              for (int i = 0; i < 5; ++i) if (i < nblk) { const fox::BlockRef br = gen(i); const int ni = br.nidx;
                  const float q2 = (nq[ni * 4] + nq[ni * 4 + 1]) + (nq[ni * 4 + 2] + nq[ni * 4 + 3]); float k2 = (nk[ni * 4] + nk[ni * 4 + 1]) + (nk[ni * 4 + 2] + nk[ni * 4 + 3]);
                  if (ni >= 64) k2 = fmaxf(k2, nc[ni - 64]);
                  const float bound = 2.0f * sqrtf(q2) * sqrtf(k2) * 1.01f + PRUNE_T / FOX_SCALE;
                  const int jl = fox::fox_jlo(br.KX, br.P0, bound, ln);
                  if (F.wave == 0 && ln == 0) ((LAS int*)(F.lds + fox::LDS_JLO))[i] = jl; }
              LDS_WAIT(); __syncthreads();
              if (F.vcu < NBS * FH) {
                  const int bs = F.vcu >> 3, h = F.vcu & 7, r_lo = ((LAS int*)(F.lds + fox::LDS_JLO))[4] * 64; ArgsP A = get_args();
                  const float* ck = A->in[I_CFK] + ((size_t)bs * PAST) * FW + h * FD; const float* cv = A->in[I_CFV] + ((size_t)bs * PAST) * FW + h * FD;
                  bf16_t* ks = WSB(WS_KS) + ((size_t)bs * SKS) * FW + h * FD; bf16_t* vs = WSB(WS_VS) + ((size_t)bs * SKS) * FW + h * FD;
#pragma unroll 4
                  for (int idx = F.wave * 64 + ln; idx < (PAST - r_lo) * 16; idx += NWAVES * 64) { const size_t o = (size_t)(r_lo + (idx >> 4)) * FW + (idx & 15) * 8;
                      const f32x4 a = *(const f32x4*)(ck + o), b = *(const f32x4*)(ck + o + 4), c = *(const f32x4*)(cv + o), d = *(const f32x4*)(cv + o + 4);
                      u32x4 w; w.x = pk2(a[0], a[1]); w.y = pk2(a[2], a[3]); w.z = pk2(b[0], b[1]); w.w = pk2(b[2], b[3]); *(u32x4*)(ks + o) = w;
                      w.x = pk2(c[0], c[1]); w.y = pk2(c[2], c[3]); w.z = pk2(d[0], d[1]); w.w = pk2(d[2], d[3]); *(u32x4*)(vs + o) = w; }
                  VM_WAIT(); __builtin_amdgcn_fence(__ATOMIC_ACQUIRE, "agent"); VM_WAIT(); __syncthreads();
              }
            }
            fox::prime(gen(0), (char*)lds, S, F.wave);
#pragma unroll 1
            for (int i = 0; i < nblk; ++i) fox::block(gen, i, nblk, (char*)lds, S, F.wave);
        }
#endif
        __syncthreads();
#ifndef NO_SGU
        {
#pragma unroll 1
            for (int it = 0; it < 3; ++it) {
                int u, g0 = 0, g1 = 4;
                if (it == 0) { u = F.vcu; if (F.vcu < 128) g1 = 3; }
                else if (it == 1) { if (F.vcu < 128) break; u = F.vcu - 128; g0 = 3; }
                else { if (F.vcu >= 128 + NBS) break; u = 128 + F.vcu; }
                if (u < 256) sgu_unit<128>(F, ws, get_args, 128 * u, nullptr, g0, g1); else sgu_unit<TS>(F, ws, get_args, MP + TS * (u - 256), out + O_GVS);
            }
        }
#endif
    }
#if (PROBE_REPEAT >> 2) & 1
    GRID_BARRIER();
    if (IN(2)) {
#if !defined(NO_FOX) && (PROBE_P2_SUB & 1)
        {
            const int nblk = F.vcu < NBS * FH ? 5 : 4;
            const FoxGen gen{ws, F.vcu, out};
            fox::Seam S;
            {
              const int ln = lane_id(); const float* nq = (const float*)(ws + WS_CTL) + CW_QN2; const float* nk = (const float*)(ws + WS_CTL) + CW_KN2; const float* nc = (const float*)(ws + WS_CTL) + CW_KN2C;
#pragma unroll
              for (int i = 0; i < 5; ++i) if (i < nblk) { const fox::BlockRef br = gen(i); const int ni = br.nidx;
                  const float q2 = (nq[ni * 4] + nq[ni * 4 + 1]) + (nq[ni * 4 + 2] + nq[ni * 4 + 3]); float k2 = (nk[ni * 4] + nk[ni * 4 + 1]) + (nk[ni * 4 + 2] + nk[ni * 4 + 3]);
                  if (ni >= 64) k2 = fmaxf(k2, nc[ni - 64]);
                  const float bound = 2.0f * sqrtf(q2) * sqrtf(k2) * 1.01f + PRUNE_T / FOX_SCALE;
                  const int jl = fox::fox_jlo(br.KX, br.P0, bound, ln);
                  if (F.wave == 0 && ln == 0) ((LAS int*)(F.lds + fox::LDS_JLO))[i] = jl; }
              LDS_WAIT(); __syncthreads();
              if (F.vcu < NBS * FH) {
                  const int bs = F.vcu >> 3, h = F.vcu & 7, r_lo = ((LAS int*)(F.lds + fox::LDS_JLO))[4] * 64; ArgsP A = get_args();
                  const float* ck = A->in[I_CFK] + ((size_t)bs * PAST) * FW + h * FD; const float* cv = A->in[I_CFV] + ((size_t)bs * PAST) * FW + h * FD;
                  bf16_t* ks = WSB(WS_KS) + ((size_t)bs * SKS) * FW + h * FD; bf16_t* vs = WSB(WS_VS) + ((size_t)bs * SKS) * FW + h * FD;
#pragma unroll 4
                  for (int idx = F.wave * 64 + ln; idx < (PAST - r_lo) * 16; idx += NWAVES * 64) { const size_t o = (size_t)(r_lo + (idx >> 4)) * FW + (idx & 15) * 8;
                      const f32x4 a = *(const f32x4*)(ck + o), b = *(const f32x4*)(ck + o + 4), c = *(const f32x4*)(cv + o), d = *(const f32x4*)(cv + o + 4);
                      u32x4 w; w.x = pk2(a[0], a[1]); w.y = pk2(a[2], a[3]); w.z = pk2(b[0], b[1]); w.w = pk2(b[2], b[3]); *(u32x4*)(ks + o) = w;
                      w.x = pk2(c[0], c[1]); w.y = pk2(c[2], c[3]); w.z = pk2(d[0], d[1]); w.w = pk2(d[2], d[3]); *(u32x4*)(vs + o) = w; }
                  VM_WAIT(); __builtin_amdgcn_fence(__ATOMIC_ACQUIRE, "agent"); VM_WAIT(); __syncthreads();
              }
            }
            fox::prime(gen(0), (char*)lds, S, F.wave);
#pragma unroll 1
            for (int i = 0; i < nblk; ++i) fox::block(gen, i, nblk, (char*)lds, S, F.wave);
        }
#endif
        __syncthreads();
#if !defined(NO_SGU) && (PROBE_P2_SUB & 2)
        {
#pragma unroll 1
            for (int u = F.vcu; u < 256 + NBS; u += (F.vcu >= 128 && F.vcu < 128 + NBS) ? 128 : 512) {
                if (u < 256) sgu_unit<128>(F, ws, get_args, 128 * u, nullptr); else sgu_unit<TS>(F, ws, get_args, MP + TS * (u - 256), out + O_GVS);
            }
        }
#endif
    }
#endif
    SEAM(2);
    if (IN(3)) {
        ProbMain S{DM, DM, DM, WSB(WS_FOGO), (const bf16_t*)(ws + WS_WOUT), MP / 256, DM / 256, F.G, bx};
        ArgsP A = get_args(); EpiResLn<true, true> E{A->in[I_XP], WSB(WS_XLB), nullptr, (float*)(ws + WS_STAT1), nullptr, nullptr, (LAS float*)(F.lds + XCH_OFF)};
        pg8::gemm_phase<EpiResLn<true, true>, ProbMain>(F.lds, S, E, F.wave);
        ProbPiece S2{256, DM, DM, WSB(WS_FOGO), (const bf16_t*)(ws + WS_WOUT), 8, DM / 256, F.G, bx};
        EpiSlab E2{(float*)(ws + WS_SLAB), DM};
        pg8::gemm_phase<EpiSlab, ProbPiece>(F.lds, S2, E2, F.wave);
    }
#if (PROBE_REPEAT >> 3) & 1
    GRID_BARRIER();
    if (IN(3)) {
        ProbMain S{DM, DM, DM, WSB(WS_FOGO), (const bf16_t*)(ws + WS_WOUT), MP / 256, DM / 256, F.G, bx};
        ArgsP A = get_args(); EpiResLn<true, true> E{A->in[I_XP], WSB(WS_XLB), nullptr, (float*)(ws + WS_STAT1), nullptr, nullptr, (LAS float*)(F.lds + XCH_OFF)};
        pg8::gemm_phase<EpiResLn<true, true>, ProbMain>(F.lds, S, E, F.wave);
        ProbPiece S2{256, DM, DM, WSB(WS_FOGO), (const bf16_t*)(ws + WS_WOUT), 8, DM / 256, F.G, bx};
        EpiSlab E2{(float*)(ws + WS_SLAB), DM};
        pg8::gemm_phase<EpiSlab, ProbPiece>(F.lds, S2, E2, F.wave);
    }
#endif
    SEAM(3);
    if (IN(4)) { { ArgsP A = get_args(); sample_combine<1>(F, R_, WSB(WS_XLB), (float*)(ws + WS_STAT1), A->in[I_XS], nullptr, nullptr, nullptr, nullptr, (const float*)(ws + WS_SLAB), 8); }
        csm_rows(F, WSB(WS_MKB), (const float*)(ws + WS_CTL) + CW_CS1, (const float*)(ws + WS_CTL) + CW_BW1, (float*)(ws + WS_CSM));
    }
    SEAM(4);
    if (IN(5)) {
        ProbQs S1{DM, DM, DM, ws, F.G, bx};
        EpiLnBf16<0, true> E1{WSB(WS_QM), DM, (const float*)(ws + WS_STAT1), (const float*)(ws + WS_CTL) + CW_CS1, (const float*)(ws + WS_CTL) + CW_BW1};
        pg8::gemm_phase<EpiLnBf16<0, true>, ProbQs, true>(F.lds, S1, E1, F.wave);
        ProbM S0{MD, DM, DM, ws, F.G, bx}; EpiBf16<0> E0{WSB(WS_MT), DM};
        pg8::gemm_phase<EpiBf16<0>, ProbM>(F.lds, S0, E0, F.wave);
        ProbVW S{MD, DM, DM, ws, F.G, bx}; EpiBf16<0> E{WSB(WS_VWT), MH * NMEM};
        pg8::gemm_phase<EpiBf16<0>, ProbVW>(F.lds, S, E, F.wave);
    }
    SEAM(5);
    if (IN(6)) {
        ProbS2 S{DM, DM, DM, ws, F.G, bx};
        EpiSm<true> E{WSB(WS_PB), (LAS float*)(F.lds + XCH_OFF), (const float*)(ws + WS_STAT1), (const float*)(ws + WS_CSM)};
        pg8::gemm_phase<EpiSm<true>, ProbS2>(F.lds, S, E, F.wave);
        ProbS S2{MD, DM, DM, ws, F.G, bx};
        EpiSm<false> E2{WSB(WS_PB), (LAS float*)(F.lds + XCH_OFF), nullptr, nullptr};
        pg8::gemm_phase<EpiSm<false>, ProbS>(F.lds, S2, E2, F.wave);
    }
#if (PROBE_REPEAT >> 6) & 1
    GRID_BARRIER();
    if (IN(6)) {
        ProbS2 S{DM, DM, DM, ws, F.G, bx};
        EpiSm<true> E{WSB(WS_PB), (LAS float*)(F.lds + XCH_OFF), (const float*)(ws + WS_STAT1), (const float*)(ws + WS_CSM)};
        pg8::gemm_phase<EpiSm<true>, ProbS2>(F.lds, S, E, F.wave);
        ProbS S2{MD, DM, DM, ws, F.G, bx};
        EpiSm<false> E2{WSB(WS_PB), (LAS float*)(F.lds + XCH_OFF), nullptr, nullptr};
        pg8::gemm_phase<EpiSm<false>, ProbS>(F.lds, S2, E2, F.wave);
    }
#endif
    SEAM(6);
    if (IN(7)) {
        ProbO S{MH * NMEM, MH * NMEM, MH * NMEM, ws, F.G, bx};
        ArgsP A = get_args(); EpiResLn<false, true> E{nullptr, WSB(WS_XLB), (const float*)(ws + WS_STAT1), (float*)(ws + WS_STAT2), A->in[I_L1G], A->in[I_L1B], (LAS float*)(F.lds + XCH_OFF)};
        pg8::gemm_phase<EpiResLn<false, true>, ProbO>(F.lds, S, E, F.wave);
        ProbPV S2{NMEM, MH * NMEM, NMEM, ws, F.G, bx};
        EpiPV E2{WSB(WS_OM)};
        pg8::gemm_phase<EpiPV, ProbPV>(F.lds, S2, E2, F.wave);
    }
    SEAM(7);
    if (IN(8)) {
        ProbPiece S2{256, DM, DM, WSB(WS_OM), (const bf16_t*)(ws + WS_WMO), 8, DM / 256, F.G, bx};
        EpiSlab E2{(float*)(ws + WS_SLAB), DM};
        pg8::gemm_phase<EpiSlab, ProbPiece>(F.lds, S2, E2, F.wave);
    }
    SEAM(8);
    if (IN(9)) { ArgsP A = get_args(); sample_combine<2>(F, R_, WSB(WS_XLB), (float*)(ws + WS_STAT2), nullptr, A->in[I_L1G], A->in[I_L1B], nullptr, nullptr, (const float*)(ws + WS_SLAB), 8); }
    SEAM(9);
    if (IN(10)) {
        ProbMain S{DM, DM, DM, WSB(WS_XLB), (const bf16_t*)(ws + WS_WUP), MT / 256, DFF / 256, F.G, bx};
        EpiLnBf16<1> E{WSB(WS_HB), DFF, (const float*)(ws + WS_STAT2), (const float*)(ws + WS_CTL) + CW_CS2, (const float*)(ws + WS_CTL) + CW_BW2};
        pg8::gemm_phase<EpiLnBf16<1>, ProbMain>(F.lds, S, E, F.wave);
    }
#if (PROBE_REPEAT >> 10) & 1
    GRID_BARRIER();
#ifdef PROBE_FIXED_OPERANDS
    if (IN(10)) {
        ProbMainFix S{{DM, DM, DM, WSB(WS_XLB), (const bf16_t*)(ws + WS_WUP), MT / 256, DFF / 256, F.G, bx}};
        EpiLnBf16<1> E{WSB(WS_HB), DFF, (const float*)(ws + WS_STAT2), (const float*)(ws + WS_CTL) + CW_CS2, (const float*)(ws + WS_CTL) + CW_BW2};
        pg8::gemm_phase<EpiLnBf16<1>, ProbMainFix>(F.lds, S, E, F.wave);
    }
    GRID_BARRIER();
#endif
    if (IN(10)) {
        ProbMain S{DM, DM, DM, WSB(WS_XLB), (const bf16_t*)(ws + WS_WUP), MT / 256, DFF / 256, F.G, bx};
        EpiLnBf16<1> E{WSB(WS_HB), DFF, (const float*)(ws + WS_STAT2), (const float*)(ws + WS_CTL) + CW_CS2, (const float*)(ws + WS_CTL) + CW_BW2};
        pg8::gemm_phase<EpiLnBf16<1>, ProbMain>(F.lds, S, E, F.wave);
    }
#endif
    SEAM(10);
    if (IN(11)) {
        ProbMain S{DFF, DFF, DFF, WSB(WS_HB), (const bf16_t*)(ws + WS_WDN), MP / 256, DM / 256, F.G, bx, 4};
        ArgsP A = get_args(); EpiResLn<false, false> E{nullptr, WSB(WS_XLB), (const float*)(ws + WS_STAT2), nullptr, A->in[I_L2G], A->in[I_L2B], (LAS float*)(F.lds + XCH_OFF)};
        pg8::gemm_phase<EpiResLn<false, false>, ProbMain>(F.lds, S, E, F.wave);
        ProbPiece S2{512, DFF, DFF, WSB(WS_HB), (const bf16_t*)(ws + WS_WDN), 16, DM / 256, F.G, bx};
        EpiSlab E2{(float*)(ws + WS_SLAB), DM};
        pg8::gemm_phase<EpiSlab, ProbPiece>(F.lds, S2, E2, F.wave);
    }
    SEAM(11);
    if (IN(12)) { ArgsP A = get_args();
        sample_combine<3>(F, R_, nullptr, nullptr, nullptr, A->in[I_L2G], A->in[I_L2B], A->in[I_L3G], A->in[I_L3B], (const float*)(ws + WS_SLAB), 16);
        ln_prompt(F, WSB(WS_XLB), R_, A->in[I_L3G], A->in[I_L3B]); }
#undef IN
#undef SEAM
#undef out
}

extern "C" void kernel_launch(void* const* d_in, const int* in_sizes, int n_in, void* d_out, int out_size, void* d_ws, size_t ws_size, hipStream_t stream) {
    static int grid = 0;
    if (grid == 0) {
        if (n_in != 27 || (size_t)out_size != O_END || ws_size < WS_END) { fprintf(stderr, "kernel_launch: unexpected shapes (n_in %d, out %d, ws %zu)\n", n_in, out_size, ws_size); grid = -1; return; }
        int dev = 0, cus = 0;
        if (hipGetDevice(&dev) != hipSuccess || hipDeviceGetAttribute(&cus, hipDeviceAttributeMultiprocessorCount, dev) != hipSuccess) { grid = -1; return; }
        if (hipFuncSetAttribute((const void*)fwd, hipFuncAttributeMaxDynamicSharedMemorySize, LDS_BYTES) != hipSuccess) { fprintf(stderr, "kernel_launch: hipFuncSetAttribute failed\n"); grid = -1; return; }
        int per_cu = 0;
        if (hipOccupancyMaxActiveBlocksPerMultiprocessor(&per_cu, (const void*)fwd, NWAVES * 64, LDS_BYTES) != hipSuccess || per_cu < 1) fprintf(stderr, "kernel_launch: occupancy query says %d\n", per_cu);
        (void)hipGetLastError();
        grid = cus;
    }
    if (grid < 0) return;
    if (hipMemsetAsync((char*)d_ws + WS_CTL, 0, CTL_ZERO_BYTES, stream) != hipSuccess) return;
    Args a{};
    for (int i = 0; i < 27; ++i) a.in[i] = (const float*)d_in[i];
    a.out = (float*)d_out; a.ws = (unsigned char*)d_ws;
    if (MK_N_LAUNCHES == 1) { a.ph_lo = 0; a.ph_hi = N_PHASES; hipLaunchKernelGGL(fwd, dim3(grid), dim3(NWAVES * 64), LDS_BYTES, stream, a); }
    else for (int li = 0; li < N_PHASES; ++li) { a.ph_lo = li; a.ph_hi = li + 1; hipLaunchKernelGGL(fwd, dim3(grid), dim3(NWAVES * 64), LDS_BYTES, stream, a); }
}
```

```cpp
#include <hip/hip_runtime.h>
#include <hip/hip_bf16.h>
#include <cstdio>
#include <cstdint>

#ifndef MK_N_LAUNCHES
#define MK_N_LAUNCHES 1
#define PROBE_P2_SUB 3
#define PROBE_REPEAT 0
#endif
#ifndef PROBE_FIX_AMASK
#define PROBE_FIX_AMASK 0
#define PROBE_FIX_BMASK 0
#endif

#define GAS __attribute__((address_space(1)))
#define LAS __attribute__((address_space(3)))
typedef unsigned short bf16_t;
typedef short bf16x8 __attribute__((ext_vector_type(8)));
typedef short s16x4 __attribute__((ext_vector_type(4)));
typedef float f32x2 __attribute__((ext_vector_type(2)));
typedef float f32x4 __attribute__((ext_vector_type(4)));
typedef float f32x16 __attribute__((ext_vector_type(16)));
typedef unsigned u32x2 __attribute__((ext_vector_type(2)));
typedef unsigned u32x4 __attribute__((ext_vector_type(4)));
typedef GAS unsigned gu32;

constexpr int DM = 2048, NB = 8, SEQ = 4096, MP = NB * SEQ, NBS = 16, TS = 32, MS = NBS * TS, MT = MP + MS, PAST = 4096;
constexpr int FW = 1024, FH = 8, FD = 128, GW = 1024, NMEM = 256, MH = 4, MD = 512, DFF = 8192, INC = 5128, NIN = 5120;
constexpr int SKS = 4160;
constexpr int MPAD = MT + 256;
constexpr float ALPHA = 1.189207115002721f;
constexpr float LN_EPS = 1e-5f;
constexpr float FOX_SCALE = 0.08838834764831845f;
constexpr float MEM_SCALE = 0.04419417382415922f;
constexpr float LOG2E = 1.4426950408889634f;

constexpr size_t O_YP = 0, O_YS = 67108864, O_FKP = 68157440, O_FVP = 101711872, O_FLP = 135266304, O_MKP = 135528448, O_MVP = 139722752,
                 O_FKS = 143917056, O_FVS = 144441344, O_FLS = 144965632, O_GVS = 144969728, O_END = 145494016;

constexpr size_t MiB = 1u << 20;
constexpr size_t WS_CTL = 0, CTL_ZERO_BYTES = 1 * MiB;
constexpr size_t WS_KXP = 1 * MiB, WS_KXS = 3 * MiB;
constexpr size_t WS_WIN = 8 * MiB, WS_WOUT = 28 * MiB, WS_WMQ = 36 * MiB, WS_WMK = 44 * MiB, WS_WMV = 52 * MiB, WS_WMO = 60 * MiB, WS_WUP = 68 * MiB, WS_WDN = 100 * MiB;
constexpr size_t WS_MEMB = 132 * MiB, WS_MKB = 140 * MiB, WS_MVB = 148 * MiB, WS_CMK = 156 * MiB, WS_CMVT = 172 * MiB;
constexpr size_t WS_XB = 188 * MiB, WS_QB = 318 * MiB, WS_KB = 384 * MiB, WS_VB = 449 * MiB, WS_UB = 514 * MiB, WS_GB = 579 * MiB;
constexpr size_t WS_HB = 188 * MiB;
constexpr size_t WS_KS = 708 * MiB, WS_VS = 838 * MiB;
constexpr size_t WS_FOGO = 188 * MiB;
constexpr size_t WS_XLB = 708 * MiB;
constexpr size_t WS_QM = 838 * MiB;
constexpr size_t WS_PB = 188 * MiB;
constexpr size_t WS_OM = 318 * MiB;
constexpr size_t WS_MT = 448 * MiB, WS_VWT = 480 * MiB;
constexpr size_t WS_WMQN = 1040 * MiB;
constexpr size_t WS_CSM = 1039 * MiB + 512 * 1024;
constexpr size_t WS_SLAB = 970 * MiB;
constexpr size_t WS_STAT1 = 1034 * MiB, WS_STAT2 = 1037 * MiB;
constexpr size_t WS_END = 1048 * MiB;
static_assert(WS_QB + (size_t)MPAD * 1024 * 2 <= WS_KB && WS_GB + (size_t)MT * 1024 * 2 <= WS_KS && WS_HB + (size_t)MT * DFF * 2 <= WS_KS, "ws map A");
static_assert(WS_VS + (size_t)NBS * SKS * 1024 * 2 <= WS_SLAB && WS_QM + (size_t)MPAD * 2048 * 2 <= WS_SLAB && WS_PB + (size_t)MPAD * 1024 * 2 <= WS_QB, "ws map B");
static_assert(WS_KXS + (size_t)NBS * FH * SKS * 8 <= WS_WIN && WS_KXP + (size_t)NB * FH * SEQ * 8 <= WS_KXS, "ws map C");

constexpr int CW_BAR = 4096;
constexpr int CW_QN2 = 8192, CW_KN2 = CW_QN2 + 192 * 4, CW_KN2C = CW_KN2 + 192 * 4;
constexpr int CW_CS1 = 16384, CW_BW1 = CW_CS1 + 2048, CW_CS2 = CW_BW1 + 2048, CW_BW2 = CW_CS2 + 8192;
static_assert((CW_BW2 + 8192) * 4 <= (int)CTL_ZERO_BYTES, "CTL words");
constexpr float PRUNE_T = 20.0f;

constexpr int RING_BYTES = 131072;
constexpr int LDSCTL_OFF = RING_BYTES, MISC_OFF = LDSCTL_OFF + 320, XCH_OFF = RING_BYTES + 1024;
constexpr int LDS_BYTES = 147456;
constexpr int NWAVES = 8;

#define LDS_WAIT() asm volatile("s_waitcnt lgkmcnt(0)" ::: "memory")
#define VM_WAIT() asm volatile("s_waitcnt vmcnt(0)" ::: "memory")

__device__ __forceinline__ unsigned cvt_pk_bf16(float lo, float hi) { unsigned r; asm volatile("v_cvt_pk_bf16_f32 %0, %1, %2" : "=v"(r) : "v"(lo), "v"(hi)); return r; }
__device__ __forceinline__ float bf2f(unsigned short h) { return __uint_as_float(((unsigned)h) << 16); }
__device__ __forceinline__ unsigned short f2bf(float f) { unsigned u = __float_as_uint(f); return (unsigned short)((u + 0x7fffu + ((u >> 16) & 1u)) >> 16); }

__device__ __forceinline__ int lane_id() { return (int)__builtin_amdgcn_mbcnt_hi(~0u, __builtin_amdgcn_mbcnt_lo(~0u, 0u)); }
__device__ __forceinline__ float shflx(float v, int m) { int l = lane_id(); asm volatile("" : "+v"(l)); return __int_as_float(__builtin_amdgcn_ds_bpermute((l ^ m) << 2, __float_as_int(v))); }
#define __shfl_xor(v, m) shflx((v), (m))

#define XB_TMO      128
#define XB_XCNT(j)  (256  + 64 * (j))
#define XB_XSUB(j)  (1280 + 64 * (j))
#define XB_XGEN(j)  (2304 + 64 * (j))
#define XB_TOP      3328
#define XB_TOPGEN   3392
#define XCD_BAR_WORDS 3456
#define XB_SPIN_CAP (1u << 18)

__device__ __forceinline__ unsigned xb_ld(unsigned* p)              { return __hip_atomic_load(p, __ATOMIC_RELAXED, __HIP_MEMORY_SCOPE_AGENT); }
__device__ __forceinline__ unsigned xb_add(unsigned* p, unsigned v) { return __hip_atomic_fetch_add(p, v, __ATOMIC_RELAXED, __HIP_MEMORY_SCOPE_AGENT); }
__device__ __forceinline__ unsigned xb_xcc_id() { return (unsigned)__builtin_amdgcn_s_getreg((3 << 11) | 20) & 0xFu; }
#define XB_SPIN(cond, bar) do { unsigned _sp = 0; while (cond) { __builtin_amdgcn_s_sleep(1); \
    if ((++_sp & 255u) == 0u) { if (xb_ld(&(bar)[XB_TMO])) break; if (_sp > XB_SPIN_CAP) { atomicAdd(&(bar)[XB_TMO], 1u); break; } } } } while (0)

struct XcdBarrier { unsigned* bar; unsigned x; volatile LAS unsigned* st; unsigned G; bool t0; };

__device__ __forceinline__ XcdBarrier xcd_barrier_post(unsigned* bar, volatile LAS unsigned* st, bool t0) {
    XcdBarrier b; b.bar = bar; b.x = xb_xcc_id(); b.st = st;
    if (t0) (void)xb_add(&bar[XB_XCNT(b.x)], 1u);
    return b;
}
__device__ __forceinline__ void xcd_barrier_complete(unsigned* bar, unsigned x, unsigned G, unsigned& nloc, unsigned& nx) {
    unsigned sum, cnt, mine, sp = 0u;
    for (;;) {
        sum = 0u; cnt = 0u; mine = 0u;
#pragma unroll
        for (unsigned j = 0; j < 16; ++j) { const unsigned c = xb_ld(&bar[XB_XCNT(j)]); sum += c; cnt += (c > 0u) ? 1u : 0u; mine = (j == x) ? c : mine; }
        if (sum == G) break;
        __builtin_amdgcn_s_sleep(1);
        if ((++sp & 255u) == 0u) { if (xb_ld(&bar[XB_TMO])) break; if (sp > XB_SPIN_CAP) { atomicAdd(&bar[XB_TMO], 1u); break; } }
    }
    nloc = mine > 0u ? mine : 1u; nx = cnt > 0u ? cnt : 1u;
}
__device__ __forceinline__ void xcd_barrier(const XcdBarrier& b) {
    asm volatile("s_waitcnt vmcnt(0)" ::: "memory");
    __syncthreads();
    if (b.t0) {
        unsigned* bar = b.bar;
        __builtin_amdgcn_s_waitcnt(0);
        unsigned nloc = b.st[0], nx = b.st[1];
        if (nloc == 0u) { xcd_barrier_complete(bar, b.x, b.G, nloc, nx); b.st[0] = nloc; b.st[1] = nx; }
        const unsigned old = xb_add(&bar[XB_XSUB(b.x)], 1u);
        const unsigned gen = old / nloc;
        if (old + 1u == (gen + 1u) * nloc) {
            __builtin_amdgcn_fence(__ATOMIC_RELEASE, "agent");
            asm volatile("s_waitcnt vmcnt(0)" ::: "memory");
            const unsigned og = xb_add(&bar[XB_TOP], 1u);
            const unsigned tg = og / nx;
            if (og + 1u == (tg + 1u) * nx) xb_add(&bar[XB_TOPGEN], 1u);
            else XB_SPIN(xb_ld(&bar[XB_TOPGEN]) == tg, bar);
            __builtin_amdgcn_fence(__ATOMIC_ACQUIRE, "agent");
            xb_add(&bar[XB_XGEN(b.x)], 1u);
            asm volatile("s_waitcnt vmcnt(0)" ::: "memory");
        } else {
            XB_SPIN(xb_ld(&bar[XB_XGEN(b.x)]) == gen, bar);
            __builtin_amdgcn_fence(__ATOMIC_ACQUIRE, "agent");
            asm volatile("s_waitcnt vmcnt(0)" ::: "memory");
        }
    }
    __syncthreads();
}

#ifndef PG8_SP2
#define PG8_SP2 true
#endif
namespace pg8 {
constexpr int BM = 256, BK = 64, HALF = 128, HTB = HALF * BK * 2, STAGE_BYTES = 8 * HTB, NXCD = 8, WGM = 8;
__host__ __device__ __forceinline__ int lds_byte(int r, int c) { const int st = (r >> 4) * 2 + (c >> 5), rr = r & 15, cc = c & 31, ob = rr * 64 + cc * 2; return st * 1024 + (ob ^ (((ob >> 9) & 1) << 5)); }
__host__ __device__ __forceinline__ void stage_rc(int b, int& R, int& C) { const int st = b / 1024, sb = b % 1024, swz = sb ^ (((sb >> 9) & 1) << 5); R = (st >> 1) * 16 + swz / 64; C = (st & 1) * 32 + (swz % 64) / 2; }
__host__ __device__ __forceinline__ int perm32(int rho) { const int n = rho >> 4, i = rho & 15; return 8 * (i >> 2) + 4 * n + (i & 3); }

struct Unit { int pm, pn, z, w; };

__device__ __forceinline__ void static_tile(int L, int nM, int nN, int& pm, int& pn, int wgm = WGM) {
    const int nwg = nM * nN;
    int wgid = L; { const int q = nwg / NXCD, r = nwg % NXCD, xcd = wgid % NXCD, off = wgid / NXCD; wgid = (xcd < r ? xcd * (q + 1) : r * (q + 1) + (xcd - r) * q) + off; }
    const int nig = wgm * nN, gid = wgid / nig, fm = gid * wgm, gsz = (nM - fm) < wgm ? (nM - fm) : wgm;
    pm = fm + ((wgid % nig) % gsz); pn = (wgid % nig) / gsz;
}

template <class Epi, class Prob, bool HALFW = false>
__device__ __forceinline__ void gemm_phase(LAS unsigned char* lds, const Prob& S, const Epi& E, int wave) {
    int tid_ = wave * 64 + lane_id(); asm volatile("" : "+v"(tid_));
    const int tid = tid_, wid = wave, lane = tid & 63, wr = wid >> 2, wc = wid & 3, fr = lane & 15, fq = lane >> 4;
    const int K = S.K, nt = K / BK, lda = S.lda, ldb = S.ldb;
    unsigned voffA[2], voffB[2];
#pragma unroll
    for (int i = 0; i < 2; ++i) { int R, C; stage_rc(tid * 16 + i * 8192, R, C); const int Rb = Epi::PERM ? ((R & ~31) + perm32(R & 31)) : R;
        voffA[i] = (unsigned)(R * lda + C) * 2u; voffB[i] = (unsigned)(Rb * ldb + C) * 2u; }
    const size_t kstep = (size_t)(BK * 2);
    const size_t hsA = (size_t)HALF * lda * 2, hsB = (size_t)HALF * ldb * 2;
    const unsigned ldsw = (unsigned)wid * 1024u;
    const int aoff = lds_byte(wr * 64 + fr, fq * 8), boff = lds_byte(wc * 32 + fr, fq * 8);
#define PG8_SA(b, h) (((b) * 2 + (h)) * HTB)
#define PG8_SB(b, h) ((4 + (b) * 2 + (h)) * HTB)
#define PG8_STAGE(bufoff, gbase, voff) do { _Pragma("unroll") for (int _i = 0; _i < 2; ++_i) \
        __builtin_amdgcn_global_load_lds((const unsigned*)((const char*)(gbase) + (voff)[_i]), (LAS unsigned*)(lds + (bufoff) + ldsw + _i * 8192), 16, 0, 0); } while (0)
#define PG8_LDA(dst, b, h) do { _Pragma("unroll") for (int m = 0; m < 4; ++m) _Pragma("unroll") for (int k = 0; k < 2; ++k) dst[m][k] = *(const LAS bf16x8*)(lds + PG8_SA(b, h) + aoff + m * 2048 + k * 1024); } while (0)
#define PG8_LDB(dst, b, h) do { _Pragma("unroll") for (int n = 0; n < 2; ++n) _Pragma("unroll") for (int k = 0; k < 2; ++k) dst[n][k] = *(const LAS bf16x8*)(lds + PG8_SB(b, h) + boff + n * 2048 + k * 1024); } while (0)
#define PG8_MMA(ai, bj, At, Bt) do { __builtin_amdgcn_s_setprio(1); _Pragma("unroll") for (int m = 0; m < 4; ++m) _Pragma("unroll") for (int n = 0; n < 2; ++n) _Pragma("unroll") for (int k = 0; k < 2; ++k) \
        acc[ai][bj][m][n] = __builtin_amdgcn_mfma_f32_16x16x32_bf16(Bt[n][k], At[m][k], acc[ai][bj][m][n], 0, 0, 0); __builtin_amdgcn_s_setprio(0); } while (0)
#define PG8_WAIT_V(n) asm volatile("s_waitcnt vmcnt(" #n ")" ::: "memory")
#define PG8_WAIT_L(n) asm volatile("s_waitcnt lgkmcnt(" #n ")" ::: "memory")
#define PG8_BAR __builtin_amdgcn_s_barrier()
#define PG8_SCHED __builtin_amdgcn_sched_barrier(0)
    Unit cur, nxt; int ui = 0;
    if (!S.next(0, cur)) return;
    f32x4 acc[2][2][4][2];
#pragma unroll
    for (int a = 0; a < 2; ++a)
#pragma unroll
        for (int b = 0; b < 2; ++b)
#pragma unroll
            for (int m = 0; m < 4; ++m)
#pragma unroll
                for (int n = 0; n < 2; ++n) acc[a][b][m][n] = (f32x4){0.f, 0.f, 0.f, 0.f};
    bf16x8 At[4][2], B0[2][2], B1[2][2];
    const char* cA = S.a_ptr(cur); const char* cB = S.b_ptr(cur);
    if constexpr (HALFW) {
    PG8_STAGE(PG8_SB(0, 0), cB, voffB); PG8_STAGE(PG8_SA(0, 0), cA, voffA); PG8_STAGE(PG8_SA(0, 1), cA + hsA, voffA);
    if (wr == 1) PG8_BAR;
    PG8_WAIT_V(2); PG8_BAR;
    PG8_STAGE(PG8_SB(1, 0), cB + kstep, voffB); PG8_STAGE(PG8_SA(1, 0), cA + kstep, voffA);
    PG8_WAIT_V(4); PG8_BAR;
    } else if constexpr (PG8_SP2) {
    PG8_STAGE(PG8_SB(0, 0), cB, voffB); PG8_STAGE(PG8_SB(0, 1), cB + hsB, voffB); PG8_STAGE(PG8_SA(0, 0), cA, voffA); PG8_STAGE(PG8_SA(0, 1), cA + hsA, voffA);
    if (wr == 1) PG8_BAR;
    PG8_WAIT_V(2); PG8_BAR;
    PG8_STAGE(PG8_SB(1, 0), cB + kstep, voffB); PG8_STAGE(PG8_SA(1, 0), cA + kstep, voffA); PG8_STAGE(PG8_SB(1, 1), cB + hsB + kstep, voffB);
    PG8_WAIT_V(6); PG8_BAR;
    } else {
    PG8_STAGE(PG8_SB(0, 0), cB, voffB); PG8_STAGE(PG8_SA(0, 0), cA, voffA); PG8_STAGE(PG8_SB(0, 1), cB + hsB, voffB); PG8_STAGE(PG8_SA(0, 1), cA + hsA, voffA);
    if (wr == 1) PG8_BAR;
    PG8_WAIT_V(4); PG8_BAR;
    PG8_STAGE(PG8_SB(1, 0), cB + kstep, voffB); PG8_STAGE(PG8_SA(1, 0), cA + kstep, voffA); PG8_STAGE(PG8_SB(1, 1), cB + hsB + kstep, voffB);
    PG8_WAIT_V(6); PG8_BAR;
    }
    for (;;) {
        const bool has_next = S.next(ui + 1, nxt);
        const char* nA = has_next ? S.a_ptr(nxt) : cA; const char* nB = has_next ? S.b_ptr(nxt) : cB;
        for (int t = 0; t < nt; t += 2) {
            const bool last = (t == nt - 2);
            const char* a1 = cA + (size_t)(t + 1) * kstep;
            const char* a2 = last ? nA : cA + (size_t)(t + 2) * kstep; const char* b2 = last ? nB : cB + (size_t)(t + 2) * kstep;
            const char* a3 = a2 + kstep; const char* b3 = b2 + kstep;
            if constexpr (HALFW) {
            PG8_LDB(B0, 0, 0); PG8_SCHED; PG8_LDA(At, 0, 0); PG8_STAGE(PG8_SA(1, 1), a1 + hsA, voffA);
            PG8_WAIT_V(6); PG8_WAIT_L(0); PG8_BAR; PG8_MMA(0, 0, At, B0); PG8_BAR; PG8_SCHED;
            PG8_LDA(At, 0, 1); PG8_STAGE(PG8_SB(0, 0), b2, voffB); PG8_STAGE(PG8_SA(0, 0), a2, voffA);
            PG8_WAIT_V(6); PG8_WAIT_L(0); PG8_BAR; PG8_MMA(1, 0, At, B0); PG8_BAR; PG8_SCHED;
            PG8_LDB(B0, 1, 0); PG8_SCHED; PG8_LDA(At, 1, 0); PG8_STAGE(PG8_SA(0, 1), a2 + hsA, voffA);
            PG8_WAIT_V(6); PG8_WAIT_L(0); PG8_BAR; PG8_MMA(0, 0, At, B0); PG8_BAR; PG8_SCHED;
            PG8_LDA(At, 1, 1); PG8_STAGE(PG8_SB(1, 0), b3, voffB); PG8_STAGE(PG8_SA(1, 0), a3, voffA);
            PG8_WAIT_V(6); PG8_WAIT_L(0); PG8_BAR; PG8_MMA(1, 0, At, B0); PG8_BAR; PG8_SCHED;
            } else if constexpr (PG8_SP2) {
            PG8_LDB(B0, 0, 0); PG8_LDB(B1, 0, 1); PG8_SCHED; PG8_LDA(At, 0, 0); PG8_STAGE(PG8_SA(1, 1), a1 + hsA, voffA);
            PG8_WAIT_V(8); PG8_WAIT_L(0); PG8_BAR; PG8_MMA(0, 0, At, B0); PG8_MMA(0, 1, At, B1); PG8_BAR; PG8_SCHED;
            PG8_LDA(At, 0, 1); PG8_STAGE(PG8_SB(0, 0), b2, voffB); PG8_STAGE(PG8_SB(0, 1), b2 + hsB, voffB); PG8_STAGE(PG8_SA(0, 0), a2, voffA);
            PG8_WAIT_V(8); PG8_WAIT_L(0); PG8_BAR; PG8_MMA(1, 0, At, B0); PG8_MMA(1, 1, At, B1); PG8_BAR; PG8_SCHED;
            PG8_LDB(B0, 1, 0); PG8_LDB(B1, 1, 1); PG8_SCHED; PG8_LDA(At, 1, 0); PG8_STAGE(PG8_SA(0, 1), a2 + hsA, voffA);
            PG8_WAIT_V(8); PG8_WAIT_L(0); PG8_BAR; PG8_MMA(0, 0, At, B0); PG8_MMA(0, 1, At, B1); PG8_BAR; PG8_SCHED;
            PG8_LDA(At, 1, 1); PG8_STAGE(PG8_SB(1, 0), b3, voffB); PG8_STAGE(PG8_SB(1, 1), b3 + hsB, voffB); PG8_STAGE(PG8_SA(1, 0), a3, voffA);
            PG8_WAIT_V(8); PG8_WAIT_L(0); PG8_BAR; PG8_MMA(1, 0, At, B0); PG8_MMA(1, 1, At, B1); PG8_BAR; PG8_SCHED;
            } else {
            PG8_LDB(B0, 0, 0); PG8_SCHED; PG8_LDA(At, 0, 0); PG8_STAGE(PG8_SA(1, 1), a1 + hsA, voffA);
            PG8_WAIT_L(8); PG8_BAR; PG8_WAIT_L(0); PG8_MMA(0, 0, At, B0); PG8_BAR; PG8_SCHED;
            PG8_LDB(B1, 0, 1); PG8_STAGE(PG8_SB(0, 0), b2, voffB);
            PG8_BAR; PG8_WAIT_L(0); PG8_MMA(0, 1, At, B1); PG8_BAR;
            PG8_LDA(At, 0, 1); PG8_STAGE(PG8_SA(0, 0), a2, voffA);
            PG8_BAR; PG8_WAIT_L(0); PG8_MMA(1, 0, At, B0); PG8_BAR; PG8_SCHED;
            PG8_STAGE(PG8_SB(0, 1), b2 + hsB, voffB);
            PG8_WAIT_V(6); PG8_BAR; PG8_MMA(1, 1, At, B1); PG8_BAR;
            PG8_LDB(B0, 1, 0); PG8_SCHED; PG8_LDA(At, 1, 0); PG8_STAGE(PG8_SA(0, 1), a2 + hsA, voffA);
            PG8_WAIT_L(8); PG8_BAR; PG8_WAIT_L(0); PG8_MMA(0, 0, At, B0); PG8_BAR; PG8_SCHED;
            PG8_LDB(B1, 1, 1); PG8_STAGE(PG8_SB(1, 0), b3, voffB);
            PG8_BAR; PG8_WAIT_L(0); PG8_MMA(0, 1, At, B1); PG8_BAR;
            PG8_LDA(At, 1, 1); PG8_STAGE(PG8_SA(1, 0), a3, voffA);
            PG8_BAR; PG8_WAIT_L(0); PG8_MMA(1, 0, At, B0); PG8_BAR; PG8_SCHED;
            PG8_STAGE(PG8_SB(1, 1), b3 + hsB, voffB);
            PG8_WAIT_V(6); PG8_BAR; PG8_MMA(1, 1, At, B1); PG8_BAR;
            }
        }
        if (wr == 0) PG8_BAR;
        E(acc, cur, wr, wc, fr, fq);
        if (!has_next) break;
#pragma unroll
        for (int a = 0; a < 2; ++a)
#pragma unroll
            for (int b = 0; b < 2; ++b)
#pragma unroll
                for (int m = 0; m < 4; ++m)
#pragma unroll
                    for (int n = 0; n < 2; ++n) acc[a][b][m][n] = (f32x4){0.f, 0.f, 0.f, 0.f};
        cur = nxt; cA = nA; cB = nB; ++ui;
        if (wr == 1) PG8_BAR;
    }
    PG8_WAIT_V(0);
    PG8_BAR;
#undef PG8_SA
#undef PG8_SB
#undef PG8_STAGE
#undef PG8_LDA
#undef PG8_LDB
#undef PG8_MMA
#undef PG8_WAIT_V
#undef PG8_WAIT_L
#undef PG8_BAR
#undef PG8_SCHED
}
}
using pg8::Unit;

__device__ __forceinline__ float gelu_tanh(float x) {
    const float u = x * (0.7978845608028654f + 0.035677408136300125f * x * x);
    const float e = __builtin_amdgcn_exp2f(u * -2.8853900817779268f);
    return x * __builtin_amdgcn_rcpf(1.0f + e);
}

struct ProbMain {
    int K, lda, ldb; const bf16_t* A; const bf16_t* Bt; int nM, nN, G, c; int wgm = 8;
    __device__ __forceinline__ bool next(int i, Unit& u) const { const int L = i * G + c; if (L >= nM * nN) return false; int pm, pn; pg8::static_tile(L, nM, nN, pm, pn, wgm); u.pm = pm; u.pn = pn; u.z = 0; u.w = 0; return true; }
    __device__ __forceinline__ const char* a_ptr(const Unit& u) const { return (const char*)A + (size_t)u.pm * 256 * lda * 2; }
    __device__ __forceinline__ const char* b_ptr(const Unit& u) const { return (const char*)Bt + (size_t)u.pn * 256 * ldb * 2; }
};
struct ProbMainFix {
    ProbMain P; int K = P.K, lda = P.lda, ldb = P.ldb;
    __device__ __forceinline__ bool next(int i, Unit& u) const { return P.next(i, u); }
    __device__ __forceinline__ const char* a_ptr(const Unit& u) const { return (const char*)P.A + (size_t)(u.pm & PROBE_FIX_AMASK) * 256 * lda * 2; }
    __device__ __forceinline__ const char* b_ptr(const Unit& u) const { return (const char*)P.Bt + (size_t)(u.pn & PROBE_FIX_BMASK) * 256 * ldb * 2; }
};
struct ProbP1 {
    int K, lda, ldb; const unsigned char* ws; int G, c;
    static constexpr int NMAIN = (MT / 256) * (NIN / 256), NMEMU = 64;
    __device__ __forceinline__ bool next(int i, Unit& u) const {
        const int L = i * G + c; if (L >= NMAIN + 2 * NMEMU) return false;
        int pm, pn, z;
        if (L < NMAIN) { pg8::static_tile(L, MT / 256, NIN / 256, pm, pn); z = 0; }
        else { const int r = L - NMAIN; z = 1 + r / NMEMU; const int q = r % NMEMU; pm = q >> 3; pn = q & 7; }
        u.pm = pm; u.pn = pn; u.z = z; u.w = 0; return true; }
    __device__ __forceinline__ const char* a_ptr(const Unit& u) const { return (const char*)ws + (u.z == 0 ? WS_XB : WS_MEMB) + (size_t)u.pm * 256 * 2048 * 2; }
    __device__ __forceinline__ const char* b_ptr(const Unit& u) const { return (const char*)ws + (u.z == 0 ? WS_WIN : (u.z == 1 ? WS_WMK : WS_WMV)) + (size_t)u.pn * 256 * 2048 * 2; }
};
struct EpiP1 {
    static constexpr bool PERM = true;
    bf16_t *QB, *KB, *VB, *UB, *GB, *KS, *VS, *MKB, *MVB; float* out; unsigned* ctl; LAS float* xch;
    __device__ __forceinline__ void operator()(f32x4 (&acc)[2][2][4][2], const Unit& u, int wr, int wc, int fr, int fq) const {
        const int rowb = u.pm * 256 + wr * 64 + fr, cl = wc * 32 + 8 * fq;
        if (u.z == 0) {
            const int seg = u.pn >> 2; const bool samp = u.pm >= (MP / 256);
            if (seg <= 1) {
                unsigned* N2 = ctl + (seg == 0 ? CW_QN2 : CW_KN2);
#pragma unroll
                for (int ai = 0; ai < 2; ++ai)
#pragma unroll
                    for (int m = 0; m < 4; ++m)
#pragma unroll
                        for (int bj = 0; bj < 2; ++bj) { const f32x4 v0 = acc[ai][bj][m][0], v1 = acc[ai][bj][m][1];
                            float ss = (v0[0] * v0[0] + v0[1] * v0[1]) + (v0[2] * v0[2] + v0[3] * v0[3]) + (v1[0] * v1[0] + v1[1] * v1[1]) + (v1[2] * v1[2] + v1[3] * v1[3]);
                            ss += __shfl_xor(ss, 16); ss += __shfl_xor(ss, 32);
                            if (fq == 0) xch[((ai * 128 + wr * 64 + m * 16 + fr) * 2 + bj) * 4 + wc] = ss; }
                LDS_WAIT(); __builtin_amdgcn_s_barrier(); asm volatile("" ::: "memory");
                { const int w8 = wr * 4 + wc, t = w8 * 64 + fq * 16 + fr;
                  const f32x4 p4 = *(const LAS f32x4*)(xch + t * 4); float ss = (p4[0] + p4[1]) + (p4[2] + p4[3]);
                  ss = fmaxf(ss, __shfl_xor(ss, 2)); ss = fmaxf(ss, __shfl_xor(ss, 4)); ss = fmaxf(ss, __shfl_xor(ss, 8)); ss = fmaxf(ss, __shfl_xor(ss, 16)); ss = fmaxf(ss, __shfl_xor(ss, 32));
                  if (fq == 0 && fr < 2) { const int head = (u.pn & 3) * 2 + fr; const int idx = samp ? 64 + ((u.pm - MP / 256) * 8 + w8) * 8 + head : (u.pm >> 4) * 8 + head;
                      atomicMax(N2 + idx * 4, __float_as_uint(ss)); } }
            }
#pragma unroll
            for (int ai = 0; ai < 2; ++ai)
#pragma unroll
                for (int m = 0; m < 4; ++m) { const int row = rowb + ai * 128 + m * 16;
#pragma unroll
                    for (int bj = 0; bj < 2; ++bj) { const int c = (u.pn & 3) * 256 + bj * 128 + cl; f32x4 v0 = acc[ai][bj][m][0], v1 = acc[ai][bj][m][1];
                        if (seg >= 3) {
#pragma unroll
                            for (int e = 0; e < 4; ++e) { v0[e] = gelu_tanh(v0[e]); v1[e] = gelu_tanh(v1[e]); } }
                        u32x4 w; w.x = cvt_pk_bf16(v0[0], v0[1]); w.y = cvt_pk_bf16(v0[2], v0[3]); w.z = cvt_pk_bf16(v1[0], v1[1]); w.w = cvt_pk_bf16(v1[2], v1[3]);
                        const size_t o1 = (size_t)row * 1024 + c;
                        if (seg == 0) *(u32x4*)(QB + o1) = w;
                        else if (seg == 3) *(u32x4*)(UB + o1) = w;
                        else if (seg == 4) *(u32x4*)(GB + o1) = w;
                        else {
                            bf16_t* const B16 = seg == 1 ? KB : VB; *(u32x4*)(B16 + o1) = w;
                            if (samp) { float* fo = out + (seg == 1 ? O_FKS : O_FVS) + (size_t)(row - MP) * 1024 + c; *(f32x4*)fo = v0; *(f32x4*)(fo + 4) = v1;
                                const int rs = row - MP, bs = rs >> 5, t = rs & 31; bf16_t* const S16 = seg == 1 ? KS : VS;
                                *(u32x4*)(S16 + ((size_t)bs * SKS + PAST + t) * 1024 + c) = w; }
                        } } }
        } else {
#pragma unroll
            for (int ai = 0; ai < 2; ++ai)
#pragma unroll
                for (int m = 0; m < 4; ++m) { const int row = rowb + ai * 128 + m * 16;
#pragma unroll
                    for (int bj = 0; bj < 2; ++bj) { const int c = u.pn * 256 + bj * 128 + cl; const f32x4 v0 = acc[ai][bj][m][0], v1 = acc[ai][bj][m][1];
                        float* fo = out + (u.z == 1 ? O_MKP : O_MVP) + (size_t)row * 2048 + c; *(f32x4*)fo = v0; *(f32x4*)(fo + 4) = v1;
                        u32x4 w; w.x = cvt_pk_bf16(v0[0], v0[1]); w.y = cvt_pk_bf16(v0[2], v0[3]); w.z = cvt_pk_bf16(v1[0], v1[1]); w.w = cvt_pk_bf16(v1[2], v1[3]);
                        *(u32x4*)((u.z == 1 ? MKB : MVB) + (size_t)row * 2048 + c) = w;
                    } }
        }
    }
};
struct ProbPiece {
    int K, lda, ldb; const bf16_t* A; const bf16_t* Bt; int S, nN, G, c;
    __device__ __forceinline__ bool next(int i, Unit& u) const { const int L = i * G + c; if (L >= 2 * nN * S) return false; const int un = L / S, kp = L - un * S; u.pm = MP / 256 + un / nN; u.pn = un % nN; u.z = kp; u.w = 0; return true; }
    __device__ __forceinline__ const char* a_ptr(const Unit& u) const { return (const char*)A + ((size_t)u.pm * 256 * lda + (size_t)u.z * K) * 2; }
    __device__ __forceinline__ const char* b_ptr(const Unit& u) const { return (const char*)Bt + ((size_t)u.pn * 256 * ldb + (size_t)u.z * K) * 2; }
};
struct EpiSlab {
    static constexpr bool PERM = false;
    float* SLAB; int ldn;
    __device__ __forceinline__ void operator()(f32x4 (&acc)[2][2][4][2], const Unit& u, int wr, int wc, int fr, int fq) const {
        const int rowb = (u.pm - MP / 256) * 256 + wr * 64 + fr, colb = u.pn * 256 + wc * 32 + 4 * fq; float* sp = SLAB + (size_t)u.z * MS * ldn;
#pragma unroll
        for (int ai = 0; ai < 2; ++ai)
#pragma unroll
            for (int m = 0; m < 4; ++m) { float* op = sp + (size_t)(rowb + ai * 128 + m * 16) * ldn + colb;
#pragma unroll
                for (int bj = 0; bj < 2; ++bj)
#pragma unroll
                    for (int n = 0; n < 2; ++n) *(f32x4*)(op + bj * 128 + n * 16) = acc[ai][bj][m][n]; }
    }
};
template <int ACT> struct EpiBf16 {
    static constexpr bool PERM = true;
    bf16_t* O; int ldo;
    __device__ __forceinline__ void operator()(f32x4 (&acc)[2][2][4][2], const Unit& u, int wr, int wc, int fr, int fq) const {
        const int rowb = u.pm * 256 + wr * 64 + fr, colb = u.pn * 256 + wc * 32 + 8 * fq;
#pragma unroll
        for (int ai = 0; ai < 2; ++ai)
#pragma unroll
            for (int m = 0; m < 4; ++m) { bf16_t* op = O + (size_t)(rowb + ai * 128 + m * 16) * ldo + colb;
#pragma unroll
                for (int bj = 0; bj < 2; ++bj) { f32x4 v0 = acc[ai][bj][m][0], v1 = acc[ai][bj][m][1];
                    if (ACT == 1) {
#pragma unroll
                        for (int e = 0; e < 4; ++e) { const float a = fmaxf(v0[e], 0.f), b = fmaxf(v1[e], 0.f); v0[e] = a * a; v1[e] = b * b; } }
                    u32x4 w; w.x = cvt_pk_bf16(v0[0], v0[1]); w.y = cvt_pk_bf16(v0[2], v0[3]); w.z = cvt_pk_bf16(v1[0], v1[1]); w.w = cvt_pk_bf16(v1[2], v1[3]);
                    *(u32x4*)(op + bj * 128) = w; } }
    }
};
__device__ __forceinline__ void row_stats8(const float* STAT, int rowb, int fq, float (&mu)[2][4], float (&rs)[2][4]) {
    f32x4 st[2][4];
#pragma unroll
    for (int ai = 0; ai < 2; ++ai)
#pragma unroll
        for (int m = 0; m < 4; ++m) st[ai][m] = *(const f32x4*)(STAT + (size_t)(rowb + ai * 128 + m * 16) * 16 + 4 * fq);
#pragma unroll
    for (int ai = 0; ai < 2; ++ai)
#pragma unroll
        for (int m = 0; m < 4; ++m) { float s = st[ai][m][0] + st[ai][m][2], q = st[ai][m][1] + st[ai][m][3];
            s += __shfl_xor(s, 16); q += __shfl_xor(q, 16); s += __shfl_xor(s, 32); q += __shfl_xor(q, 32);
            const float mean = s * (1.0f / DM); mu[ai][m] = mean; rs[ai][m] = 1.0f / sqrtf(fmaxf(q * (1.0f / DM) - mean * mean, 0.f) + LN_EPS); }
}
template <bool FIRST, bool WRITE_S> struct EpiResLn {
    static constexpr bool PERM = false;
    const float* res; bf16_t* XLB; const float* STATi; float* STATo; const float* g; const float* b; LAS float* xch;
    struct RBuf { f32x4 f[4]; u32x2 h[4]; f32x4 st; };
    __device__ __forceinline__ void load_res(RBuf& r, int row, int colb, int fq) const {
#pragma unroll
        for (int bj = 0; bj < 2; ++bj)
#pragma unroll
            for (int n = 0; n < 2; ++n) { const int c = colb + bj * 128 + n * 16;
                if (FIRST) r.f[bj * 2 + n] = *(const f32x4*)(res + (size_t)row * DM + c); else r.h[bj * 2 + n] = *(const u32x2*)(XLB + (size_t)row * DM + c); }
        if (!FIRST) r.st = *(const f32x4*)(STATi + (size_t)row * 16 + 4 * fq);
    }
    __device__ __forceinline__ void operator()(f32x4 (&acc)[2][2][4][2], const Unit& u, int wr, int wc, int fr, int fq) const {
        const int rowb = u.pm * 256 + wr * 64 + fr, colb = u.pn * 256 + wc * 32 + 4 * fq;
        f32x4 gv[2][2], bv[2][2];
        RBuf rb[2]; load_res(rb[0], rowb, colb, fq);
        if (!FIRST) {
#pragma unroll
            for (int bj = 0; bj < 2; ++bj)
#pragma unroll
                for (int n = 0; n < 2; ++n) { gv[bj][n] = *(const f32x4*)(g + colb + bj * 128 + n * 16); bv[bj][n] = *(const f32x4*)(b + colb + bj * 128 + n * 16); } }
#pragma unroll
        for (int ai = 0; ai < 2; ++ai)
#pragma unroll
            for (int m = 0; m < 4; ++m) { const int idx = ai * 4 + m, row = rowb + ai * 128 + m * 16, lr = ai * 128 + wr * 64 + m * 16 + fr;
                if (idx + 1 < 8) load_res(rb[(idx + 1) & 1], rowb + ((idx + 1) >> 2) * 128 + ((idx + 1) & 3) * 16, colb, fq);
                const RBuf& rc = rb[idx & 1];
                float mu = 0.f, rs = 1.f;
                if (!FIRST) { float sq = rc.st[0] + rc.st[2], qq = rc.st[1] + rc.st[3];
                    sq += __shfl_xor(sq, 16); qq += __shfl_xor(qq, 16); sq += __shfl_xor(sq, 32); qq += __shfl_xor(qq, 32);
                    mu = sq * (1.0f / DM); rs = 1.0f / sqrtf(fmaxf(qq * (1.0f / DM) - mu * mu, 0.f) + LN_EPS); }
                bf16_t* xp = XLB + (size_t)row * DM; float s = 0.f, ss = 0.f;
#pragma unroll
                for (int bj = 0; bj < 2; ++bj)
#pragma unroll
                    for (int n = 0; n < 2; ++n) { const int c = colb + bj * 128 + n * 16; f32x4 x;
                        if (FIRST) x = rc.f[bj * 2 + n];
                        else { const u32x2 w = rc.h[bj * 2 + n]; x = (f32x4){__uint_as_float(w.x << 16), __uint_as_float(w.x & 0xffff0000u), __uint_as_float(w.y << 16), __uint_as_float(w.y & 0xffff0000u)};
                            x = (x - mu) * rs * gv[bj][n] + bv[bj][n]; }
                        const f32x4 y = x * ALPHA + acc[ai][bj][m][n];
                        u32x2 w; w.x = cvt_pk_bf16(y[0], y[1]); w.y = cvt_pk_bf16(y[2], y[3]); *(u32x2*)(xp + c) = w;
                        if (WRITE_S) { s += (y[0] + y[1]) + (y[2] + y[3]); ss += (y[0] * y[0] + y[1] * y[1]) + (y[2] * y[2] + y[3] * y[3]); } }
                if (WRITE_S) { s += __shfl_xor(s, 16); s += __shfl_xor(s, 32); ss += __shfl_xor(ss, 16); ss += __shfl_xor(ss, 32);
                    if (fq == 0) *(LAS f32x2*)(xch + (lr * 4 + wc) * 2) = (f32x2){s, ss}; } }
        if (WRITE_S) {
            LDS_WAIT(); __builtin_amdgcn_s_barrier(); asm volatile("" ::: "memory");
            const int t = (wr * 4 + wc) * 64 + fq * 16 + fr;
            if (t < 256) { const f32x4 a = *(const LAS f32x4*)(xch + t * 8), c = *(const LAS f32x4*)(xch + t * 8 + 4);
                *(f32x2*)(STATo + (size_t)(u.pm * 256 + t) * 16 + u.pn * 2) = (f32x2){(a[0] + a[2]) + (c[0] + c[2]), (a[1] + a[3]) + (c[1] + c[3])}; }
        }
    }
};
template <int ACT, bool HALFW = false> struct EpiLnBf16 {
    static constexpr bool PERM = true;
    bf16_t* O; int ldo; const float* STAT; const float* cs; const float* bw;
    __device__ __forceinline__ void operator()(f32x4 (&acc)[2][2][4][2], const Unit& u, int wr, int wc, int fr, int fq) const {
        constexpr int NBJ = HALFW ? 1 : 2;
        const int rowb = u.pm * 256 + wr * 64 + fr, colb = u.pn * 256 + (HALFW ? u.w * 128 : 0) + wc * 32 + 8 * fq;
        f32x4 c0[2], c1[2], w0[2], w1[2];
#pragma unroll
        for (int bj = 0; bj < NBJ; ++bj) { c0[bj] = *(const f32x4*)(cs + colb + bj * 128); c1[bj] = *(const f32x4*)(cs + colb + bj * 128 + 4); w0[bj] = *(const f32x4*)(bw + colb + bj * 128); w1[bj] = *(const f32x4*)(bw + colb + bj * 128 + 4); }
        float mu8[2][4], rs8[2][4]; row_stats8(STAT, rowb, fq, mu8, rs8);
#pragma unroll
        for (int ai = 0; ai < 2; ++ai)
#pragma unroll
            for (int m = 0; m < 4; ++m) { const int row = rowb + ai * 128 + m * 16; const float rs = rs8[ai][m], t = -rs * mu8[ai][m];
                bf16_t* op = O + (size_t)row * ldo + colb;
#pragma unroll
                for (int bj = 0; bj < NBJ; ++bj) { f32x4 v0 = acc[ai][bj][m][0] * rs + (c0[bj] * t + w0[bj]), v1 = acc[ai][bj][m][1] * rs + (c1[bj] * t + w1[bj]);
                    if (ACT == 1) {
#pragma unroll
                        for (int e = 0; e < 4; ++e) { const float a = fmaxf(v0[e], 0.f), b = fmaxf(v1[e], 0.f); v0[e] = a * a; v1[e] = b * b; } }
                    u32x4 w; w.x = cvt_pk_bf16(v0[0], v0[1]); w.y = cvt_pk_bf16(v0[2], v0[3]); w.z = cvt_pk_bf16(v1[0], v1[1]); w.w = cvt_pk_bf16(v1[2], v1[3]);
                    *(u32x4*)(op + bj * 128) = w; } }
    }
};
constexpr int NQSU = 32;
struct ProbM {
    int K, lda, ldb; const unsigned char* ws; int G, c;
    __device__ __forceinline__ bool next(int i, Unit& u) const { if (c < NQSU) return false; const int L = i * (G - NQSU) + (c - NQSU); if (L >= 256) return false; u.pm = L >> 3; u.pn = L & 7; u.z = 0; u.w = 0; return true; }
    __device__ __forceinline__ const char* a_ptr(const Unit& u) const { return (const char*)ws + WS_MKB + ((size_t)(u.pm >> 2) * 256 * 2048 + (u.pm & 3) * 512) * 2; }
    __device__ __forceinline__ const char* b_ptr(const Unit& u) const { return (const char*)ws + WS_WMQN + ((size_t)u.pn * 256 * 2048 + (u.pm & 3) * 512) * 2; }
};
struct ProbVW {
    int K, lda, ldb; const unsigned char* ws; int G, c;
    __device__ __forceinline__ bool next(int i, Unit& u) const { if (c < NQSU) return false; const int L = i * (G - NQSU) + (G - 1 - c); if (L >= 256) return false; u.pm = L >> 2; u.pn = L & 3; u.z = 0; u.w = 0; return true; }
    __device__ __forceinline__ const char* a_ptr(const Unit& u) const { return (const char*)ws + WS_WMO + ((size_t)(u.pm & 7) * 256 * 2048 + u.pn * 512) * 2; }
    __device__ __forceinline__ const char* b_ptr(const Unit& u) const { return (const char*)ws + WS_MVB + ((size_t)(u.pm >> 3) * 256 * 2048 + u.pn * 512) * 2; }
};
struct ProbQs {
    int K, lda, ldb; const unsigned char* ws; int G, c;
    __device__ __forceinline__ bool next(int i, Unit& u) const { if (i > 0 || c >= NQSU) return false; u.pm = MP / 256 + (c >> 4); u.pn = (c >> 1) & 7; u.z = 0; u.w = c & 1; return true; }
    __device__ __forceinline__ const char* a_ptr(const Unit& u) const { return (const char*)ws + WS_XLB + (size_t)u.pm * 256 * 2048 * 2; }
    __device__ __forceinline__ const char* b_ptr(const Unit& u) const { return (const char*)ws + WS_WMQ + ((size_t)u.pn * 256 + u.w * 128) * 2048 * 2; }
};
struct ProbS2 {
    int K, lda, ldb; const unsigned char* ws; int G, c;
    __device__ __forceinline__ bool next(int i, Unit& u) const { const int L = i * G + c; if (L >= NB * 16 * MH) return false; const int b = L >> 6, r = L & 63; u.pm = b * SEQ + (r >> 2) * 256; u.pn = r & 3; u.z = 256; u.w = b; return true; }
    __device__ __forceinline__ const char* a_ptr(const Unit& u) const { return (const char*)ws + WS_XLB + (size_t)u.pm * 2048 * 2; }
    __device__ __forceinline__ const char* b_ptr(const Unit& u) const { return (const char*)ws + WS_MT + ((size_t)u.w * 1024 + u.pn * 256) * 2048 * 2; }
};
struct ProbO {
    int K, lda, ldb; const unsigned char* ws; int G, c;
    __device__ __forceinline__ bool next(int i, Unit& u) const { const int L = i * G + c; if (L >= NB * 16 * 8) return false; int pm, pn; pg8::static_tile(L, NB * 16, 8, pm, pn); u.pm = pm; u.pn = pn; u.z = 0; u.w = 0; return true; }
    __device__ __forceinline__ const char* a_ptr(const Unit& u) const { return (const char*)ws + WS_PB + (size_t)u.pm * 256 * 1024 * 2; }
    __device__ __forceinline__ const char* b_ptr(const Unit& u) const { return (const char*)ws + WS_VWT + ((size_t)(u.pm >> 4) * 2048 + u.pn * 256) * 1024 * 2; }
};
struct ProbS {
    int K, lda, ldb; const unsigned char* ws; int G, c;
    static constexpr int NPU = 0, NSU = NBS * MH;
    __device__ __forceinline__ bool next(int i, Unit& u) const {
        const int L = i * G + c; if (L >= NPU + NSU) return false;
        int pm, pn, z, w;
        if (L < NPU) { const int b = L >> 6, r = L & 63; pm = b * SEQ + (r >> 2) * 256; pn = r & 3; z = 256; w = b; }
        else { const int r = L - NPU, bs = r >> 2; pm = MP + bs * TS; pn = r & 3; z = TS; w = 8 + bs; }
        u.pm = pm; u.pn = pn; u.z = z; u.w = w; return true; }
    __device__ __forceinline__ const char* a_ptr(const Unit& u) const { return (const char*)ws + WS_QM + ((size_t)u.pm * 2048 + u.pn * 512) * 2; }
    __device__ __forceinline__ const char* b_ptr(const Unit& u) const { return (const char*)ws + (u.w < 8 ? WS_MKB + (size_t)u.w * 256 * 2048 * 2 : WS_CMK + (size_t)(u.w - 8) * 256 * 2048 * 2) + (size_t)u.pn * 512 * 2; }
};
template <bool FOLD> struct EpiSm {
    static constexpr bool PERM = true;
    bf16_t* PB; LAS float* xch;
    const float* STAT; const float* csM;
    __device__ __forceinline__ void operator()(f32x4 (&acc)[2][2][4][2], const Unit& u, int wr, int wc, int fr, int fq) const {
        constexpr float SC = MEM_SCALE * LOG2E;
        LAS float* xmax = xch; LAS float* xsum = xch + 1024;
        if (FOLD) {
            const float* cp = csM + u.w * 1024 + u.pn * 256 + wc * 32 + 8 * fq; f32x4 c0[2], c1[2], w0[2], w1[2];
#pragma unroll
            for (int bj = 0; bj < 2; ++bj) { c0[bj] = *(const f32x4*)(cp + bj * 128); c1[bj] = *(const f32x4*)(cp + bj * 128 + 4); w0[bj] = *(const f32x4*)(cp + 8192 + bj * 128); w1[bj] = *(const f32x4*)(cp + 8192 + bj * 128 + 4); }
            float mu8[2][4], rs8[2][4]; row_stats8(STAT, u.pm + wr * 64 + fr, fq, mu8, rs8);
#pragma unroll
            for (int ai = 0; ai < 2; ++ai)
#pragma unroll
                for (int m = 0; m < 4; ++m) { const float rs = rs8[ai][m], t = -rs * mu8[ai][m];
#pragma unroll
                    for (int bj = 0; bj < 2; ++bj) { acc[ai][bj][m][0] = acc[ai][bj][m][0] * rs + (c0[bj] * t + w0[bj]); acc[ai][bj][m][1] = acc[ai][bj][m][1] * rs + (c1[bj] * t + w1[bj]); } }
        }
#pragma unroll
        for (int ai = 0; ai < 2; ++ai)
#pragma unroll
            for (int m = 0; m < 4; ++m) { float mx = -3.0e38f;
#pragma unroll
                for (int bj = 0; bj < 2; ++bj)
#pragma unroll
                    for (int n = 0; n < 2; ++n) { f32x4 v = acc[ai][bj][m][n] * SC; acc[ai][bj][m][n] = v; mx = fmaxf(fmaxf(mx, fmaxf(v[0], v[1])), fmaxf(v[2], v[3])); }
                mx = fmaxf(mx, __shfl_xor(mx, 16)); mx = fmaxf(mx, __shfl_xor(mx, 32));
                if (fq == 0) xmax[(ai * 128 + wr * 64 + m * 16 + fr) * 4 + wc] = mx; }
        LDS_WAIT(); __builtin_amdgcn_s_barrier(); asm volatile("" ::: "memory");
#pragma unroll
        for (int ai = 0; ai < 2; ++ai)
#pragma unroll
            for (int m = 0; m < 4; ++m) { const int lr = ai * 128 + wr * 64 + m * 16 + fr; const f32x4 mm = *(const LAS f32x4*)(xmax + lr * 4);
                const float M = fmaxf(fmaxf(mm[0], mm[1]), fmaxf(mm[2], mm[3])); float s = 0.f;
#pragma unroll
                for (int bj = 0; bj < 2; ++bj)
#pragma unroll
                    for (int n = 0; n < 2; ++n) { f32x4 v = acc[ai][bj][m][n];
#pragma unroll
                        for (int e = 0; e < 4; ++e) v[e] = __builtin_amdgcn_exp2f(v[e] - M);
                        acc[ai][bj][m][n] = v; s += (v[0] + v[1]) + (v[2] + v[3]); }
                s += __shfl_xor(s, 16); s += __shfl_xor(s, 32);
                if (fq == 0) xsum[lr * 4 + wc] = s; }
        LDS_WAIT(); __builtin_amdgcn_s_barrier(); asm volatile("" ::: "memory");
#pragma unroll
        for (int ai = 0; ai < 2; ++ai)
#pragma unroll
            for (int m = 0; m < 4; ++m) { const int lr = ai * 128 + wr * 64 + m * 16 + fr; const f32x4 ss = *(const LAS f32x4*)(xsum + lr * 4);
                const float inv = 1.0f / ((ss[0] + ss[1]) + (ss[2] + ss[3]));
                if (lr < u.z) { bf16_t* op = PB + (size_t)(u.pm + lr) * 1024 + u.pn * 256 + wc * 32 + 8 * fq;
#pragma unroll
                    for (int bj = 0; bj < 2; ++bj) { const f32x4 v0 = acc[ai][bj][m][0] * inv, v1 = acc[ai][bj][m][1] * inv;
                        u32x4 w; w.x = cvt_pk_bf16(v0[0], v0[1]); w.y = cvt_pk_bf16(v0[2], v0[3]); w.z = cvt_pk_bf16(v1[0], v1[1]); w.w = cvt_pk_bf16(v1[2], v1[3]);
                        *(u32x4*)(op + bj * 128) = w; } } }
    }
};
struct ProbPV {
    int K, lda, ldb; const unsigned char* ws; int G, c;
    static constexpr int NPU = 0, NSU = NBS * MH * 2;
    __device__ __forceinline__ bool next(int i, Unit& u) const {
        const int L = i * G + c; if (L >= NPU + NSU) return false;
        int pm, pn, z, w;
        if (L < NPU) { const int b = L >> 7, r = L & 127; pm = b * SEQ + (r >> 3) * 256; pn = r & 7; z = 256; w = b; }
        else { const int r = L - NPU, bs = r >> 3; pm = MP + bs * TS; pn = r & 7; z = TS; w = 8 + bs; }
        u.pm = pm; u.pn = pn; u.z = z; u.w = w; return true; }
    __device__ __forceinline__ const char* a_ptr(const Unit& u) const { return (const char*)ws + WS_PB + ((size_t)u.pm * 1024 + (u.pn >> 1) * 256) * 2; }
    __device__ __forceinline__ const char* b_ptr(const Unit& u) const { return (const char*)ws + (WS_CMVT + (size_t)(u.w - 8) * 2048 * 256 * 2) + (size_t)u.pn * 256 * 256 * 2; }
};
struct EpiPV {
    static constexpr bool PERM = true;
    bf16_t* OM;
    __device__ __forceinline__ void operator()(f32x4 (&acc)[2][2][4][2], const Unit& u, int wr, int wc, int fr, int fq) const {
#pragma unroll
        for (int ai = 0; ai < 2; ++ai)
#pragma unroll
            for (int m = 0; m < 4; ++m) { const int lr = ai * 128 + wr * 64 + m * 16 + fr;
                if (lr < u.z) { bf16_t* op = OM + (size_t)(u.pm + lr) * 2048 + u.pn * 256 + wc * 32 + 8 * fq;
#pragma unroll
                    for (int bj = 0; bj < 2; ++bj) { const f32x4 v0 = acc[ai][bj][m][0], v1 = acc[ai][bj][m][1];
                        u32x4 w; w.x = cvt_pk_bf16(v0[0], v0[1]); w.y = cvt_pk_bf16(v0[2], v0[3]); w.z = cvt_pk_bf16(v1[0], v1[1]); w.w = cvt_pk_bf16(v1[2], v1[3]);
                        *(u32x4*)(op + bj * 128) = w; } } }
    }
};

namespace fox {
using bf16 = __hip_bfloat16;
constexpr int D = 128, LDQ = 1024, LDO = 2048;
constexpr int NW = 8, QBLK = 32, KVBLK = 64, QB = NW * QBLK;
constexpr int SHM_V = KVBLK * D * 2, SHM_K = KVBLK * D * 2;
constexpr int LDS_BIAS = 2 * SHM_V + 2 * SHM_K + NW * 64 * 4;
constexpr int LDS_JLO = LDS_BIAS + 2 * 256;
constexpr int LDS_BYTES = LDS_JLO + 32;
constexpr float SCALE = FOX_SCALE;
constexpr float THR = 8.f;
constexpr unsigned WBIG = 1u << 30;

#define KSWZ(row, colB) ((row) * 256 + ((colB) ^ (((row) & 7) << 4)))
#define SBAR() __builtin_amdgcn_sched_barrier(0)
__device__ __forceinline__ int v_st(int k, int c) { const int kk = (k & ~0xC) | ((k & 4) << 1) | ((k & 8) >> 1); return ((kk >> 3) * 4 + (c >> 5)) * 512 + ((kk & 7) * 32 + (c & 31)) * 2; }
__device__ __forceinline__ int v_rd_base(int lane) { return ((lane & 3) << 3) | (((lane >> 2) & 3) << 6) | (((lane >> 4) & 1) << 5) | (((lane >> 5) & 1) << 8); }
constexpr int v_rd_off(int d0, int ks, int half) { return d0 * 512 + ks * 4096 + half * 2048; }
__device__ __forceinline__ int crow(int r, int hi) { return (r & 3) + 8 * (r >> 2) + 4 * hi; }
__device__ __forceinline__ unsigned cvtpk(float lo, float hi) { unsigned r; asm volatile("v_cvt_pk_bf16_f32 %0, %1, %2" : "=v"(r) : "v"(lo), "v"(hi)); return r; }
__device__ __forceinline__ bf16x8 load8(const bf16* p) { return *reinterpret_cast<const bf16x8*>(p); }
__device__ __forceinline__ void mask_tile(f32x16& p0, f32x16& p1, int dq, unsigned W) {
    const float NEG = -__builtin_inff();
#pragma unroll
    for (int r = 0; r < 16; ++r) {
        const int c = (r & 3) + 8 * (r >> 2);
        if ((unsigned)(dq - c) >= W) p0[r] = NEG;
        if ((unsigned)(dq - c - 32) >= W) p1[r] = NEG;
    }
}
__device__ __forceinline__ void partialSM(f32x16& p0, f32x16& p1, float& m_reg, float& mn, float& alpha) {
    float pmax = p0[0];
#pragma unroll
    for (int r = 1; r < 16; ++r) pmax = fmaxf(pmax, p0[r]);
#pragma unroll
    for (int r = 0; r < 16; ++r) pmax = fmaxf(pmax, p1[r]);
    { auto rr = __builtin_amdgcn_permlane32_swap(__float_as_uint(pmax), __float_as_uint(pmax), false, false);
      pmax = fmaxf(__uint_as_float(rr[0]), __uint_as_float(rr[1])); }
    constexpr float C2 = 1.4426950408889634f * SCALE;
    if (__builtin_expect(__all((pmax - m_reg) * SCALE <= THR), 1)) { mn = m_reg; alpha = 1.f; }
    else { mn = fmaxf(m_reg, pmax); alpha = __builtin_amdgcn_exp2f((m_reg - mn) * C2); m_reg = mn; }
    const float mnL = -mn * C2;
#pragma unroll
    for (int r = 0; r < 16; ++r) p0[r] = fmaf(p0[r], C2, mnL);
#pragma unroll
    for (int r = 0; r < 16; ++r) p1[r] = fmaf(p1[r], C2, mnL);
#pragma unroll
    for (int r = 0; r < 16; ++r) p0[r] = __builtin_amdgcn_exp2f(p0[r]);
}
__device__ __forceinline__ void finishSM(f32x16& p0, f32x16& p1, float alpha, float& l_reg, bf16x8& pa0, bf16x8& pa1, bf16x8& pa2, bf16x8& pa3) {
#pragma unroll
    for (int r = 0; r < 16; ++r) p1[r] = __builtin_amdgcn_exp2f(p1[r]);
    float ps = 0;
#pragma unroll
    for (int r = 0; r < 16; ++r) ps += p0[r];
#pragma unroll
    for (int r = 0; r < 16; ++r) ps += p1[r];
    { auto rr = __builtin_amdgcn_permlane32_swap(__float_as_uint(ps), __float_as_uint(ps), false, false);
      ps = __uint_as_float(rr[0]) + __uint_as_float(rr[1]); }
    l_reg = l_reg * alpha + ps;
#define PK4(P, B_, OUT) do { unsigned a0 = cvtpk(P[B_+0], P[B_+1]), a1 = cvtpk(P[B_+2], P[B_+3]);                          \
        unsigned b0 = cvtpk(P[B_+4], P[B_+5]), b1 = cvtpk(P[B_+6], P[B_+7]);                                             \
        auto r0 = __builtin_amdgcn_permlane32_swap(a0, b0, false, false); auto r1 = __builtin_amdgcn_permlane32_swap(a1, b1, false, false); \
        u32x4 w = {r0[0], r1[0], r0[1], r1[1]}; OUT = *reinterpret_cast<bf16x8*>(&w); } while (0)
    PK4(p0, 0, pa0); PK4(p0, 8, pa1); PK4(p1, 0, pa2); PK4(p1, 8, pa3);
#undef PK4
}
template <int KB>
__device__ __forceinline__ void qkt(f32x16& p0, f32x16& p1, const char* K_lds, const char* B_lds, int r32, int hi, const bf16x8* qr, bool act) {
    if (!act) { const float NEG = -__builtin_inff();
#pragma unroll
        for (int r = 0; r < 16; ++r) { p0[r] = NEG; p1[r] = NEG; } return; }
    { const float* bl = (const float*)(B_lds + KB * 256) + 4 * hi;
#pragma unroll
      for (int g = 0; g < 4; ++g) { const f32x4 q0 = *(const f32x4*)(bl + 8 * g), q1 = *(const f32x4*)(bl + 32 + 8 * g);
#pragma unroll
          for (int e = 0; e < 4; ++e) { p0[4 * g + e] = q0[e]; p1[4 * g + e] = q1[e]; } } }
    const char* kb[4];
#pragma unroll
    for (int dd = 0; dd < 4; ++dd) kb[dd] = K_lds + KB * SHM_K + KSWZ(r32, (dd * 16 + hi * 8) * 2);
#pragma unroll
    for (int d0 = 0; d0 < 8; ++d0) { const char* a = kb[d0 & 3] + (d0 >> 2) * 128;
        bf16x8 b0 = *reinterpret_cast<const bf16x8*>(a);
        bf16x8 b1 = *reinterpret_cast<const bf16x8*>(a + 32 * 256);
        p0 = __builtin_amdgcn_mfma_f32_32x32x16_bf16(b0, qr[d0], p0, 0, 0, 0);
        p1 = __builtin_amdgcn_mfma_f32_32x32x16_bf16(b1, qr[d0], p1, 0, 0, 0); }
}
template <int VB>
__device__ __forceinline__ void pv_tile(f32x16* o, int vb0, bf16x8 pa0, bf16x8 pa1, bf16x8 pa2, bf16x8 pa3, bool act) {
    if (!act) return;
#define TRRD(dst, off) asm volatile("ds_read_b64_tr_b16 %0, %1 offset:%2" : "=&v"(dst) : "v"(vb0), "i"(off) : "memory")
#define PV_D0(d0) do { s16x4 l0, l1, l2, l3, h0, h1, h2, h3; constexpr int b_ = VB * SHM_V + v_rd_off(d0, 0, 0); \
        TRRD(l0, b_); TRRD(h0, b_ + 2048); TRRD(l1, b_ + 4096); TRRD(h1, b_ + 6144); TRRD(l2, b_ + 8192); TRRD(h2, b_ + 10240); TRRD(l3, b_ + 12288); TRRD(h3, b_ + 14336); \
        asm volatile("s_waitcnt lgkmcnt(0)" ::: "memory"); SBAR();   \
        o[d0] = __builtin_amdgcn_mfma_f32_32x32x16_bf16(pa0, (bf16x8){l0[0], l0[1], l0[2], l0[3], h0[0], h0[1], h0[2], h0[3]}, o[d0], 0, 0, 0);   \
        o[d0] = __builtin_amdgcn_mfma_f32_32x32x16_bf16(pa1, (bf16x8){l1[0], l1[1], l1[2], l1[3], h1[0], h1[1], h1[2], h1[3]}, o[d0], 0, 0, 0);   \
        o[d0] = __builtin_amdgcn_mfma_f32_32x32x16_bf16(pa2, (bf16x8){l2[0], l2[1], l2[2], l2[3], h2[0], h2[1], h2[2], h2[3]}, o[d0], 0, 0, 0);   \
        o[d0] = __builtin_amdgcn_mfma_f32_32x32x16_bf16(pa3, (bf16x8){l3[0], l3[1], l3[2], l3[3], h3[0], h3[1], h3[2], h3[3]}, o[d0], 0, 0, 0); } while (0)
    PV_D0(0); PV_D0(1); PV_D0(2); PV_D0(3);
#undef PV_D0
#undef TRRD
}

__device__ __forceinline__ int fox_jlo(const float* KX, int P0, float bound, int lane) {
    const int nt0 = P0 >> 6;
    const float thr = KX[P0] - bound;
    const float xv = lane < nt0 ? KX[64 * lane + 63] : 3.0e38f;
    return (int)__builtin_popcountll(__ballot(xv <= thr));
}
struct BlockRef { const bf16* Q; const bf16* K; const bf16* V; bf16* O; const float* KX; int P0; int skv; int nvalid; int nidx; };
struct Seam { bf16x8 qr[8]; bf16x8 st_v0, st_v1, st_k0, st_k1; float st_b; };
#define ROW(p, k0, rr) ((p) + (size_t)((k0) + (rr)) * LDQ + sc)
#define VMW() asm volatile("s_waitcnt vmcnt(0)" ::: "memory")
#define VMWN(n) asm volatile("s_waitcnt vmcnt(%0)" :: "i"(n) : "memory")
#define SLOAD_K(Kp, Bp, k0) do { S.st_b = (Bp)[(k0) + lane]; S.st_k0 = load8(ROW(Kp, k0, sr)); S.st_k1 = load8(ROW(Kp, k0, 32 + sr)); } while (0)
#define SLOAD_V(Vp, k0) do { S.st_v0 = load8(ROW(Vp, k0, sr)); S.st_v1 = load8(ROW(Vp, k0, 32 + sr)); } while (0)
#define SLOAD_H(Kp, Vp, Bp, k0) do { SLOAD_K(Kp, Bp, k0); SLOAD_V(Vp, k0); } while (0)
#define SWRITE_HK(bf) do { if (wid == 0) ((float*)(B_lds + (bf) * 256))[lane] = S.st_b; *(bf16x8*)(K_lds + (bf) * SHM_K + kws) = S.st_k0; *(bf16x8*)(K_lds + (bf) * SHM_K + kws + 32 * 256) = S.st_k1; } while (0)
#define SWRITE_HV(bf) do { *(bf16x8*)(V_lds + (bf) * SHM_V + vst0) = S.st_v0; *(bf16x8*)(V_lds + (bf) * SHM_V + vst1) = S.st_v1; } while (0)
#define SWRITE_H(bf) do { SWRITE_HV(bf); SWRITE_HK(bf); } while (0)
__device__ __forceinline__ void prime(const BlockRef& cur, char* lds, Seam& S, int wave) {
    int tid_ = wave * 64 + lane_id(); asm volatile("" : "+v"(tid_));
    const int tid = tid_, wid = wave, lane = tid & 63, r32 = lane & 31, hi = lane >> 5;
    const int sr = tid >> 4, sc = (tid & 15) * 8, kws = KSWZ(sr, sc * 2); char* K_lds = lds + 2 * SHM_V; char* B_lds = lds + LDS_BIAS;
#pragma unroll
    for (int d0 = 0; d0 < 8; ++d0) S.qr[d0] = load8(cur.Q + (size_t)(wid * QBLK + r32) * LDQ + d0 * 16 + hi * 8);
    const int kb0 = __builtin_amdgcn_readfirstlane(((const int*)(lds + LDS_JLO))[0]) * KVBLK;
    SLOAD_H(cur.K, cur.V, cur.KX, kb0); VMW(); SWRITE_HK(0);
    __syncthreads();
}
template <class Gen>
__device__ __forceinline__ void block(const Gen& gen, int bi, int nblk, char* lds, Seam& S, int wave) {
    const BlockRef cur = gen(bi);
    int tid_ = wave * 64 + lane_id(); asm volatile("" : "+v"(tid_));
    const int tid = tid_, wid = wave, lane = tid & 63, r32 = lane & 31, hi = lane >> 5;
    const unsigned W = WBIG;
    const int j_lo = __builtin_amdgcn_readfirstlane(((const int*)(lds + LDS_JLO))[bi]);
    int j_hi = (cur.P0 + QB - 1) / KVBLK + 1; if (j_hi > cur.skv / KVBLK) j_hi = cur.skv / KVBLK;
    const int NT = j_hi - j_lo;
    const int qlo = cur.P0 + wid * QBLK, qm = qlo + r32 - 4 * hi;
    const bool won = wid * QBLK < cur.nvalid;
    char* V_lds = lds; char* K_lds = lds + 2 * SHM_V; char* B_lds = lds + LDS_BIAS;
    float* ws = (float*)(lds + 2 * SHM_V + 2 * SHM_K) + wid * 64; float* li_l = ws, * al_l = ws + 32;
    float m_reg = -1e30f, l_reg = 0; f32x16 o[4] = {};
    const int sr = tid >> 4, sc = (tid & 15) * 8, vst0 = v_st(sr, sc), vst1 = v_st(32 + sr, sc), kws = KSWZ(sr, sc * 2);
    const int vb0 = (int)(uintptr_t)V_lds + v_rd_base(lane);
    const bf16* Kh = cur.K; const bf16* Vh = cur.V; const float* Bh = cur.KX;
#define RESC(a) do { if (__any((a) < 1.f)) { if (hi == 0) al_l[r32] = (a); asm volatile("s_waitcnt lgkmcnt(0)" ::: "memory");              \
                     for (int d_ = 0; d_ < 4; ++d_) for (int r = 0; r < 16; ++r) o[d_][r] *= al_l[crow(r, hi)]; } } while (0)
#define KBASE(t) ((j_lo + (t)) * KVBLK)
#define ACT(t) (won && KBASE(t) <= qlo + QBLK - 1)
    const bool emit = cur.nvalid == QB;
#define OKP (gen.outp + O_FKP + (cur.K - (const bf16*)(gen.ws + WS_KB)))
#define OVP (OKP + (O_FVP - O_FKP))
#define F4LO(w_) (f32x4){__uint_as_float(((const u32x4&)(w_)).x << 16), __uint_as_float(((const u32x4&)(w_)).x & 0xffff0000u), __uint_as_float(((const u32x4&)(w_)).y << 16), __uint_as_float(((const u32x4&)(w_)).y & 0xffff0000u)}
#define F4HI(w_) (f32x4){__uint_as_float(((const u32x4&)(w_)).z << 16), __uint_as_float(((const u32x4&)(w_)).z & 0xffff0000u), __uint_as_float(((const u32x4&)(w_)).w << 16), __uint_as_float(((const u32x4&)(w_)).w & 0xffff0000u)}
#define EMIT_KV(t) do { if (emit && KBASE(t) >= cur.P0) { const size_t o0_ = (size_t)(KBASE(t) + sr) * LDQ + sc, o1_ = o0_ + (size_t)32 * LDQ;              \
        *(f32x4*)(OKP + o0_) = F4LO(S.st_k0); *(f32x4*)(OKP + o0_ + 4) = F4HI(S.st_k0); asm volatile("" ::: "memory"); *(f32x4*)(OKP + o1_) = F4LO(S.st_k1); *(f32x4*)(OKP + o1_ + 4) = F4HI(S.st_k1); asm volatile("" ::: "memory"); \
        *(f32x4*)(OVP + o0_) = F4LO(S.st_v0); *(f32x4*)(OVP + o0_ + 4) = F4HI(S.st_v0); asm volatile("" ::: "memory"); *(f32x4*)(OVP + o1_) = F4LO(S.st_v1); *(f32x4*)(OVP + o1_ + 4) = F4HI(S.st_v1); } } while (0)
#define MASKT(P0_, P1_, t) do { const int kb_ = KBASE(t); if (ACT(t) && (kb_ + KVBLK - 1 > qlo)) mask_tile(P0_, P1_, qm - kb_, W); } while (0)
    constexpr int NQL = 8;
#define SEAM_K0() do { VMWN(NQL); SWRITE_HK(0); SBAR(); } while (0)
    f32x16 pA0, pA1, pB0, pB1; float mnA, mnB, alA, alB; bf16x8 pa0, pa1, pa2, pa3;
    SWRITE_HV(0); SBAR();
    if (NT > 1) { SLOAD_H(Kh, Vh, Bh, KBASE(1)); }
    SBAR(); qkt<0>(pA0, pA1, K_lds, B_lds, r32, hi, S.qr, ACT(0));
    MASKT(pA0, pA1, 0); partialSM(pA0, pA1, m_reg, mnA, alA);
    if (NT > 1) { VMW(); SWRITE_H(1); EMIT_KV(1); }
    __syncthreads();
#define HALF_STEP(PX0, PX1, mnX, alX, PY0, PY1, alY, t, KB, VB, SB) do {                                                      \
        SBAR(); if ((t) + 1 < NT) { SLOAD_K(Kh, Bh, KBASE((t) + 1)); SBAR(); }            \
        qkt<KB>(PX0, PX1, K_lds, B_lds, r32, hi, S.qr, ACT(t));                                                                  \
        finishSM(PY0, PY1, alY, l_reg, pa0, pa1, pa2, pa3); SBAR();                                                           \
        if ((t) + 1 < NT) { SLOAD_V(Vh, KBASE((t) + 1)); SBAR(); }                                                             \
        pv_tile<VB>(o, vb0, pa0, pa1, pa2, pa3, ACT((t) - 1)); MASKT(PX0, PX1, (t)); partialSM(PX0, PX1, m_reg, mnX, alX);     \
        __syncthreads();                                                                                                      \
        if ((t) + 1 < NT) { VMW(); SWRITE_H(SB); EMIT_KV((t) + 1); }                                                          \
        RESC(alX); __syncthreads(); } while (0)
    for (int t = 1; t + 1 < NT; t += 2) {
        HALF_STEP(pB0, pB1, mnB, alB, pA0, pA1, alA, t, 1, 0, 0);
        HALF_STEP(pA0, pA1, mnA, alA, pB0, pB1, alB, t + 1, 0, 1, 1);
    }
    const bool even = (NT & 1) == 0;
    if (even) { SBAR(); qkt<1>(pB0, pB1, K_lds, B_lds, r32, hi, S.qr, ACT(NT - 1)); SBAR(); }
    const int bn = bi + 1 < nblk ? bi + 1 : bi; const BlockRef nxt = gen(bn);
    const int kbn = __builtin_amdgcn_readfirstlane(((const int*)(lds + LDS_JLO))[bn]) * KVBLK;
    SLOAD_H(nxt.K, nxt.V, nxt.KX, kbn); SBAR();
#pragma unroll
    for (int d0 = 0; d0 < 8; ++d0) S.qr[d0] = load8(nxt.Q + (size_t)(wid * QBLK + r32) * LDQ + d0 * 16 + hi * 8);
    SBAR();
    finishSM(pA0, pA1, alA, l_reg, pa0, pa1, pa2, pa3); SBAR();
    pv_tile<0>(o, vb0, pa0, pa1, pa2, pa3, ACT(even ? NT - 2 : NT - 1));
    if (even) { MASKT(pB0, pB1, NT - 1); partialSM(pB0, pB1, m_reg, mnB, alB); __syncthreads(); RESC(alB);
        finishSM(pB0, pB1, alB, l_reg, pa0, pa1, pa2, pa3); SBAR(); pv_tile<1>(o, vb0, pa0, pa1, pa2, pa3, ACT(NT - 1)); }
    SBAR(); SEAM_K0();
    if (hi == 0) li_l[r32] = l_reg; asm volatile("s_waitcnt lgkmcnt(0)" ::: "memory");
    float rli[16];
#pragma unroll
    for (int r = 0; r < 16; ++r) rli[r] = __builtin_amdgcn_rcpf(li_l[crow(r, hi)]);
    bf16* Ow = cur.O + (size_t)(wid * QBLK) * LDO;
    if (won) {
    int ln = lane; asm volatile("" : "+v"(ln));
    const int r32e = ln & 31, hie = ln >> 5;
#pragma unroll
    for (int r = 0; r < 16; ++r) { const int orow = crow(r, hie);
#pragma unroll
        for (int d0 = 0; d0 < 4; ++d0) { const float v = o[d0][r] * rli[r];
            const float vn = __shfl_xor(v, 1);
            if ((r32e & 1) == 0) *(unsigned*)(Ow + (size_t)orow * LDO + d0 * 32 + r32e) = cvtpk(v, vn); } }
    }
    if (emit && KBASE(0) >= cur.P0) {
        const size_t o0_ = (size_t)(KBASE(0) + sr) * LDQ + sc, o1_ = o0_ + (size_t)32 * LDQ;
        const u32x4 k0_ = *(const u32x4*)(cur.K + o0_), k1_ = *(const u32x4*)(cur.K + o1_), v0_ = *(const u32x4*)(cur.V + o0_), v1_ = *(const u32x4*)(cur.V + o1_);
        *(f32x4*)(OKP + o0_) = F4LO(k0_); *(f32x4*)(OKP + o0_ + 4) = F4HI(k0_); *(f32x4*)(OKP + o1_) = F4LO(k1_); *(f32x4*)(OKP + o1_ + 4) = F4HI(k1_);
        *(f32x4*)(OVP + o0_) = F4LO(v0_); *(f32x4*)(OVP + o0_ + 4) = F4HI(v0_); *(f32x4*)(OVP + o1_) = F4LO(v1_); *(f32x4*)(OVP + o1_ + 4) = F4HI(v1_);
    }
    __syncthreads();
#undef RESC
#undef KBASE
#undef ACT
#undef MASKT
#undef EMIT_KV
#undef OKP
#undef OVP
#undef F4LO
#undef F4HI
#undef SEAM_K0
#undef HALF_STEP
}
#undef ROW
#undef VMW
#undef VMWN
#undef SLOAD_H
#undef SLOAD_K
#undef SLOAD_V
#undef SWRITE_HK
#undef SWRITE_HV
#undef SWRITE_H
#undef KSWZ
#undef SBAR
}

struct Frame {
    LAS unsigned char* lds;
    int wave, vcu, G;
};
__device__ __forceinline__ float wave_sum(float v) {
#pragma unroll
    for (int o = 1; o < 64; o <<= 1) v += __shfl_xor(v, o);
    return v;
}
__device__ __forceinline__ unsigned pk2(float lo, float hi) { return cvt_pk_bf16(lo, hi); }

struct TItem { const float* W; bf16_t* WT; const float* gv; const float* bv; float* cs; float* bw; int ldw, K, k0, nsrc, ndst, fold; };
__device__ __forceinline__ void titem_load(const TItem& d, f32x4 (&tv)[8], int lane) {
#pragma unroll
    for (int i = 0; i < 8; ++i) tv[i] = *(const f32x4*)(d.W + (size_t)(d.k0 + 8 * i + (lane >> 3)) * d.ldw + d.nsrc + 4 * (lane & 7));
}
template <bool FOLD>
__device__ __forceinline__ void titem_finish(const TItem& d, const f32x4 (&tv)[8], LAS float* scr, int lane) {
#pragma unroll
    for (int i = 0; i < 8; ++i) { LAS float* p = scr + (8 * i + (lane >> 3)) * 33 + 4 * (lane & 7); p[0] = tv[i][0]; p[1] = tv[i][1]; p[2] = tv[i][2]; p[3] = tv[i][3]; }
    LDS_WAIT(); asm volatile("" ::: "memory");
    const int c = lane & 7; const int k0 = d.k0;
    f32x4 g0, g1, b0, b1;
    if (FOLD) { g0 = *(const f32x4*)(d.gv + k0 + 8 * c); g1 = *(const f32x4*)(d.gv + k0 + 8 * c + 4); b0 = *(const f32x4*)(d.bv + k0 + 8 * c); b1 = *(const f32x4*)(d.bv + k0 + 8 * c + 4); }
#pragma unroll
    for (int j = 0; j < 4; ++j) { const int n = (lane >> 3) + 8 * j; const LAS float* s = scr + (8 * c) * 33 + n;
        float w[8];
#pragma unroll
        for (int e = 0; e < 8; ++e) w[e] = s[e * 33];
        u32x4 o;
        if (FOLD) { o.x = pk2(w[0] * g0[0], w[1] * g0[1]); o.y = pk2(w[2] * g0[2], w[3] * g0[3]); o.z = pk2(w[4] * g1[0], w[5] * g1[1]); o.w = pk2(w[6] * g1[2], w[7] * g1[3]);
            float csum = 0.f, bsum = 0.f;
#pragma unroll
            for (int e = 0; e < 4; ++e) { csum += __uint_as_float(o[e] << 16) + __uint_as_float(o[e] & 0xffff0000u); }
            bsum = ((w[0] * b0[0] + w[1] * b0[1]) + (w[2] * b0[2] + w[3] * b0[3])) + ((w[4] * b1[0] + w[5] * b1[1]) + (w[6] * b1[2] + w[7] * b1[3]));
            csum += __shfl_xor(csum, 1); csum += __shfl_xor(csum, 2); csum += __shfl_xor(csum, 4); bsum += __shfl_xor(bsum, 1); bsum += __shfl_xor(bsum, 2); bsum += __shfl_xor(bsum, 4);
            if (c == 0) { atomicAdd(d.cs + d.ndst + n, csum); atomicAdd(d.bw + d.ndst + n, bsum); } }
        else { o.x = pk2(w[0], w[1]); o.y = pk2(w[2], w[3]); o.z = pk2(w[4], w[5]); o.w = pk2(w[6], w[7]); }
        *(GAS u32x4*)(d.WT + (size_t)(d.ndst + n) * d.K + k0 + 8 * c) = o; }
    LDS_WAIT(); asm volatile("" ::: "memory");
}
__device__ __forceinline__ void cvt_flat(const float* src, bf16_t* dst, size_t n, int bshift, size_t bstride, size_t gt, size_t NGT) {
    const size_t mask = ((size_t)1 << bshift) - 1;
    size_t e = gt * 8;
    for (; e + 3 * NGT * 8 < n; e += 4 * NGT * 8) {
        f32x4 a[4], b[4];
#pragma unroll
        for (int i = 0; i < 4; ++i) { a[i] = *(const f32x4*)(src + e + i * NGT * 8); b[i] = *(const f32x4*)(src + e + i * NGT * 8 + 4); }
#pragma unroll
        for (int i = 0; i < 4; ++i) { const size_t ee = e + i * NGT * 8; u32x4 w; w.x = pk2(a[i][0], a[i][1]); w.y = pk2(a[i][2], a[i][3]); w.z = pk2(b[i][0], b[i][1]); w.w = pk2(b[i][2], b[i][3]);
            *(u32x4*)(dst + (ee >> bshift) * bstride + (ee & mask)) = w; } }
    for (; e < n; e += NGT * 8) { const f32x4 a = *(const f32x4*)(src + e), b = *(const f32x4*)(src + e + 4);
        u32x4 w; w.x = pk2(a[0], a[1]); w.y = pk2(a[2], a[3]); w.z = pk2(b[0], b[1]); w.w = pk2(b[2], b[3]);
        *(u32x4*)(dst + (e >> bshift) * bstride + (e & mask)) = w; }
}
__device__ __forceinline__ float log_sigmoid_f(float y) { return y >= 0.f ? -log1pf(expf(-y)) : y - log1pf(expf(y)); }

__device__ __forceinline__ void ln_prompt(Frame& F, const bf16_t* XLB, float* R, const float* g, const float* b) {
    const int gw = F.vcu * NWAVES + F.wave, NGW = F.G * NWAVES;
    int lane_ = lane_id(); asm volatile("" : "+v"(lane_)); const int lane = lane_;
    f32x4 gg[8], bb[8];
#pragma unroll
    for (int j = 0; j < 8; ++j) { gg[j] = *(const f32x4*)(g + 256 * j + 4 * lane); bb[j] = *(const f32x4*)(b + 256 * j + 4 * lane); }
    for (int m = gw; m < MP; m += NGW) {
        const bf16_t* xp = XLB + (size_t)m * DM + 4 * lane; float* rp = R + (size_t)m * DM + 4 * lane; f32x4 v[8]; float s = 0.f;
#pragma unroll
        for (int j = 0; j < 8; ++j) { const u32x2 w = *(const u32x2*)(xp + 256 * j); v[j] = (f32x4){__uint_as_float(w.x << 16), __uint_as_float(w.x & 0xffff0000u), __uint_as_float(w.y << 16), __uint_as_float(w.y & 0xffff0000u)};
            s += (v[j][0] + v[j][1]) + (v[j][2] + v[j][3]); }
        const float mean = wave_sum(s) * (1.f / DM); float q = 0.f;
#pragma unroll
        for (int j = 0; j < 8; ++j) { v[j] = v[j] - mean; q += (v[j][0] * v[j][0] + v[j][1] * v[j][1]) + (v[j][2] * v[j][2] + v[j][3] * v[j][3]); }
        const float rstd = 1.0f / sqrtf(wave_sum(q) * (1.f / DM) + LN_EPS);
#pragma unroll
        for (int j = 0; j < 8; ++j) *(f32x4*)(rp + 256 * j) = v[j] * rstd * gg[j] + bb[j];
    }
}
template <int MODE>
__device__ __forceinline__ void sample_combine(Frame& F, float* R, bf16_t* XLB, float* STATo, const float* xs, const float* gp, const float* bp, const float* gf, const float* bf, const float* SLAB, int S) {
    const int gw = F.wave * F.G + F.vcu, NGW = F.G * NWAVES;
    int lane_ = lane_id(); asm volatile("" : "+v"(lane_)); const int lane = lane_;
    for (int ms = gw; ms < MS; ms += NGW) { const int m = MP + ms;
        float* rp = R + (size_t)m * DM + 4 * lane; const float* xp = (MODE == 1 ? xs + (size_t)ms * DM : R + (size_t)m * DM) + 4 * lane; f32x4 v[8];
#pragma unroll
        for (int j = 0; j < 8; ++j) v[j] = *(const f32x4*)(xp + 256 * j);
        if (MODE >= 2) { float s = 0.f;
#pragma unroll
            for (int j = 0; j < 8; ++j) s += (v[j][0] + v[j][1]) + (v[j][2] + v[j][3]);
            const float mean = wave_sum(s) * (1.f / DM); float q = 0.f;
#pragma unroll
            for (int j = 0; j < 8; ++j) { v[j] = v[j] - mean; q += (v[j][0] * v[j][0] + v[j][1] * v[j][1]) + (v[j][2] * v[j][2] + v[j][3] * v[j][3]); }
            const float rstd = 1.0f / sqrtf(wave_sum(q) * (1.f / DM) + LN_EPS);
#pragma unroll
            for (int j = 0; j < 8; ++j) v[j] = v[j] * rstd * *(const f32x4*)(gp + 256 * j + 4 * lane) + *(const f32x4*)(bp + 256 * j + 4 * lane); }
#pragma unroll
        for (int j = 0; j < 8; ++j) v[j] = v[j] * ALPHA;
#pragma unroll 1
        for (int kp = 0; kp < S; kp += 4) { const float* sp = SLAB + ((size_t)kp * MS + ms) * DM + 4 * lane; f32x4 t0[8], t1[8], t2[8], t3[8];
#pragma unroll
            for (int j = 0; j < 8; ++j) { t0[j] = *(const f32x4*)(sp + 256 * j); t1[j] = *(const f32x4*)(sp + (size_t)MS * DM + 256 * j); t2[j] = *(const f32x4*)(sp + (size_t)2 * MS * DM + 256 * j); t3[j] = *(const f32x4*)(sp + (size_t)3 * MS * DM + 256 * j); }
#pragma unroll
            for (int j = 0; j < 8; ++j) v[j] += (t0[j] + t1[j]) + (t2[j] + t3[j]); }
        if (MODE <= 2) { float s = 0.f, q = 0.f;
#pragma unroll
            for (int j = 0; j < 8; ++j) { *(f32x4*)(rp + 256 * j) = v[j]; u32x2 w; w.x = pk2(v[j][0], v[j][1]); w.y = pk2(v[j][2], v[j][3]); *(u32x2*)(XLB + (size_t)m * DM + 256 * j + 4 * lane) = w;
                s += (v[j][0] + v[j][1]) + (v[j][2] + v[j][3]); q += (v[j][0] * v[j][0] + v[j][1] * v[j][1]) + (v[j][2] * v[j][2] + v[j][3] * v[j][3]); }
            s = wave_sum(s); q = wave_sum(q);
            if (lane < 8) *(f32x2*)(STATo + (size_t)m * 16 + 2 * lane) = lane == 0 ? (f32x2){s, q} : (f32x2){0.f, 0.f};
        } else { float s = 0.f;
#pragma unroll
            for (int j = 0; j < 8; ++j) s += (v[j][0] + v[j][1]) + (v[j][2] + v[j][3]);
            const float mean = wave_sum(s) * (1.f / DM); float q = 0.f;
#pragma unroll
            for (int j = 0; j < 8; ++j) { v[j] = v[j] - mean; q += (v[j][0] * v[j][0] + v[j][1] * v[j][1]) + (v[j][2] * v[j][2] + v[j][3] * v[j][3]); }
            const float rstd = 1.0f / sqrtf(wave_sum(q) * (1.f / DM) + LN_EPS);
#pragma unroll
            for (int j = 0; j < 8; ++j) *(f32x4*)(rp + 256 * j) = v[j] * rstd * *(const f32x4*)(gf + 256 * j + 4 * lane) + *(const f32x4*)(bf + 256 * j + 4 * lane); }
    }
}

__device__ __forceinline__ void csm_rows(Frame& F, const bf16_t* MKB, const float* cs1, const float* bw1, float* csM) {
    const int gw = F.vcu * NWAVES + F.wave, NGW = F.G * NWAVES;
    int lane_ = lane_id(); asm volatile("" : "+v"(lane_)); const int lane = lane_;
    for (int r = gw; r < NB * NMEM; r += NGW) { const bf16_t* mp = MKB + (size_t)r * DM + lane * 32; float a = 0.f, c = 0.f;
#pragma unroll
        for (int q = 0; q < 4; ++q) { const u32x4 w = *(const u32x4*)(mp + 8 * q); const f32x4 c0 = *(const f32x4*)(cs1 + lane * 32 + 8 * q), c1 = *(const f32x4*)(cs1 + lane * 32 + 8 * q + 4), b0 = *(const f32x4*)(bw1 + lane * 32 + 8 * q), b1 = *(const f32x4*)(bw1 + lane * 32 + 8 * q + 4);
#pragma unroll
            for (int e = 0; e < 2; ++e) { const float x0 = __uint_as_float(w[e] << 16), x1 = __uint_as_float(w[e] & 0xffff0000u), x2 = __uint_as_float(w[2 + e] << 16), x3 = __uint_as_float(w[2 + e] & 0xffff0000u);
                a += x0 * c0[2 * e] + x1 * c0[2 * e + 1] + x2 * c1[2 * e] + x3 * c1[2 * e + 1]; c += x0 * b0[2 * e] + x1 * b0[2 * e + 1] + x2 * b1[2 * e] + x3 * b1[2 * e + 1]; } }
#pragma unroll
        for (int o = 1; o < 16; o <<= 1) { a += __shfl_xor(a, o); c += __shfl_xor(c, o); }
        if ((lane & 15) == 0) { const int b = r >> 8, key = r & 255, h = lane >> 4; csM[b * 1024 + h * 256 + key] = a; csM[8192 + b * 1024 + h * 256 + key] = c; }
    }
}
__device__ __forceinline__ void cvt_rowscale(const float* src, bf16_t* dst, const float* g, size_t n, size_t gt, size_t NGT) {
#pragma unroll 4
    for (size_t e = gt * 8; e < n; e += NGT * 8) { const f32x4 a = *(const f32x4*)(src + e), b = *(const f32x4*)(src + e + 4); const float gk = g[e >> 11];
        u32x4 w; w.x = pk2(a[0] * gk, a[1] * gk); w.y = pk2(a[2] * gk, a[3] * gk); w.z = pk2(b[0] * gk, b[1] * gk); w.w = pk2(b[2] * gk, b[3] * gk); *(u32x4*)(dst + e) = w; }
}

constexpr int SGU_TS = 576;
constexpr int SGU_WS = 272;
constexpr int SGU_WOFF = 128 * SGU_TS, SGU_SOFF = SGU_WOFF + 128 * SGU_WS;
template <int NROWS, class AP>
__device__ __forceinline__ void sgu_unit(Frame& F, unsigned char* ws, AP (*getp)(), int row0, float* gvs  , int g0 = 0, int g1 = 4  ) {
    constexpr int nrows = NROWS; constexpr bool FULL = NROWS == 128;
    const bf16_t* GB = (const bf16_t*)(ws + WS_GB);
    LAS unsigned char* tile = F.lds; LAS unsigned char* wtile = F.lds + SGU_WOFF; LAS float* stats = (LAS float*)(F.lds + SGU_SOFF);
    int tid_ = F.wave * 64 + lane_id(); asm volatile("" : "+v"(tid_));
    const int tid = tid_, lane = tid & 63, wid = F.wave, r32 = lane & 31, hi = lane >> 5;
    { const int r = tid >> 2, q4 = tid & 3; float s = 0.f, ss = 0.f;
      if (FULL || r < nrows) { const bf16_t* gp = GB + (size_t)(row0 + r) * GW + q4 * 256;
#pragma unroll 16
          for (int i = 0; i < 32; ++i) { const u32x4 a = *(const u32x4*)(gp + 8 * i);
#pragma unroll
              for (int e = 0; e < 4; ++e) { const float x0 = __uint_as_float(a[e] << 16), x1 = __uint_as_float(a[e] & 0xffff0000u); s += x0 + x1; ss = fmaf(x0, x0, ss); ss = fmaf(x1, x1, ss); } } }
      s += __shfl_xor(s, 1); ss += __shfl_xor(ss, 1); s += __shfl_xor(s, 2); ss += __shfl_xor(ss, 2);
      if ((FULL || r < nrows) && q4 == 0) { const float mean = s * (1.f / GW); const float var = fmaxf(ss * (1.f / GW) - mean * mean, 0.f); stats[2 * r] = mean; stats[2 * r + 1] = 1.0f / sqrtf(var + LN_EPS); } }
    LDS_WAIT(); __syncthreads();
    constexpr int nmb = nrows / 32;
#pragma unroll 1
    for (int g = g0; g < g1; ++g) {
        { const float* ln_g = getp()->in[10]; const float* ln_b = getp()->in[11]; const float* wsp = getp()->in[12];
          u32x4 av[8]; f32x4 wa[4][2];
#pragma unroll
          for (int k = 0; k < 8; ++k) { const int idx = tid + 512 * k, r = idx >> 5, ch = idx & 31; if (FULL || r < nrows) av[k] = *(const u32x4*)(GB + (size_t)(row0 + r) * GW + g * 256 + ch * 8); }
#pragma unroll
          for (int k = 0; k < 4; ++k) { const int idx = tid + 512 * k, t = idx >> 4, s0 = (idx & 15) * 8; if (FULL || t < nrows) { const float* wp = wsp + ((size_t)g * 128 + t) * 128 + s0; wa[k][0] = *(const f32x4*)wp; wa[k][1] = *(const f32x4*)(wp + 4); } }
#pragma unroll
          for (int k = 0; k < 8; ++k) { const int idx = tid + 512 * k, r = idx >> 5, ch = idx & 31;
            if (FULL || r < nrows) { const int col = g * 256 + ch * 8; const u32x4 a = av[k];
                const float mean = stats[2 * r], rstd = stats[2 * r + 1];
                const f32x4 g0 = *(const f32x4*)(ln_g + col), g1 = *(const f32x4*)(ln_g + col + 4), b0 = *(const f32x4*)(ln_b + col), b1 = *(const f32x4*)(ln_b + col + 4);
                f32x4 y0, y1;
#pragma unroll
                for (int e = 0; e < 2; ++e) { y0[2 * e] = (__uint_as_float(a[e] << 16) - mean) * rstd * g0[2 * e] + b0[2 * e]; y0[2 * e + 1] = (__uint_as_float(a[e] & 0xffff0000u) - mean) * rstd * g0[2 * e + 1] + b0[2 * e + 1];
                    y1[2 * e] = (__uint_as_float(a[2 + e] << 16) - mean) * rstd * g1[2 * e] + b1[2 * e]; y1[2 * e + 1] = (__uint_as_float(a[2 + e] & 0xffff0000u) - mean) * rstd * g1[2 * e + 1] + b1[2 * e + 1]; }
                if (gvs) { float* gp = gvs + (size_t)(row0 - MP + r) * GW + col; *(f32x4*)gp = y0; *(f32x4*)(gp + 4) = y1; }
                u32x4 w; w.x = pk2(y0[0], y0[1]); w.y = pk2(y0[2], y0[3]); w.z = pk2(y1[0], y1[1]); w.w = pk2(y1[2], y1[3]);
                *(LAS u32x4*)(tile + r * SGU_TS + ch * 16) = w; } }
#pragma unroll
          for (int k = 0; k < 4; ++k) { const int idx = tid + 512 * k, t = idx >> 4, s0 = (idx & 15) * 8;
            if (FULL || t < nrows) { const f32x4 a0 = wa[k][0], a1 = wa[k][1];
                u32x4 aw; aw.x = pk2(s0 + 0 <= t ? a0[0] : 0.f, s0 + 1 <= t ? a0[1] : 0.f); aw.y = pk2(s0 + 2 <= t ? a0[2] : 0.f, s0 + 3 <= t ? a0[3] : 0.f);
                aw.z = pk2(s0 + 4 <= t ? a1[0] : 0.f, s0 + 5 <= t ? a1[1] : 0.f); aw.w = pk2(s0 + 6 <= t ? a1[2] : 0.f, s0 + 7 <= t ? a1[3] : 0.f);
                *(LAS u32x4*)(wtile + t * SGU_WS + s0 * 2) = aw; } } }
        LDS_WAIT(); __syncthreads();
        u32x4 uvp[8];
#pragma unroll
        for (int k = 0; k < 8; ++k) { const int idx = tid + 512 * k, r = idx >> 5, ch = idx & 31; if (FULL || r < nrows) uvp[k] = *(const u32x4*)((const bf16_t*)(ws + WS_UB) + (size_t)(row0 + r) * GW + g * 256 + ch * 8); }
        const int i16 = lane & 15;
        const LAS unsigned char* bbase = tile + (8 * hi + (i16 >> 2)) * SGU_TS + (32 * wid + 16 * ((lane >> 4) & 1) + 4 * (i16 & 3)) * 2;
        f32x16 acc[4];
#pragma unroll
        for (int mb = 0; mb < 4; ++mb) { acc[mb] = f32x16{};
            if (mb < nmb) { const LAS unsigned char* abase = wtile + (32 * mb + r32) * SGU_WS + 16 * hi;
#pragma unroll
                for (int ks = 0; ks < 8; ++ks) { if (ks <= 2 * mb + 1) {
                    const bf16x8 af = *(const LAS bf16x8*)(abase + 32 * ks);
                    const s16x4 lo = __builtin_bit_cast(s16x4, __builtin_amdgcn_ds_read_tr16_b64_v4i16((LAS s16x4*)(bbase + 16 * ks * SGU_TS)));
                    const s16x4 hh = __builtin_bit_cast(s16x4, __builtin_amdgcn_ds_read_tr16_b64_v4i16((LAS s16x4*)(bbase + (16 * ks + 4) * SGU_TS)));
                    const bf16x8 bf = (bf16x8){lo[0], lo[1], lo[2], lo[3], hh[0], hh[1], hh[2], hh[3]};
                    acc[mb] = __builtin_amdgcn_mfma_f32_32x32x16_bf16(af, bf, acc[mb], 0, 0, 0); } } } }
        LDS_WAIT(); __syncthreads();
        const float* b_s = getp()->in[13];
#pragma unroll
        for (int mb = 0; mb < 4; ++mb) { if (mb < nmb) {
#pragma unroll
            for (int r = 0; r < 16; ++r) { const int t = 32 * mb + (r & 3) + 8 * (r >> 2) + 4 * hi;
                *(LAS unsigned short*)(tile + t * SGU_TS + (32 * wid + r32) * 2) = f2bf(acc[mb][r] + b_s[g * 128 + t]); } } }
        LDS_WAIT(); __syncthreads();
#pragma unroll
        for (int k = 0; k < 8; ++k) { const int idx = tid + 512 * k, r = idx >> 5, ch = idx & 31;
            if (FULL || r < nrows) { const int col = g * 256 + ch * 8; const u32x4 sv = *(const LAS u32x4*)(tile + r * SGU_TS + ch * 16);
                const u32x4 uv = uvp[k]; u32x4 w;
#pragma unroll
                for (int e = 0; e < 4; ++e) w[e] = pk2(__uint_as_float(sv[e] << 16) * __uint_as_float(uv[e] << 16), __uint_as_float(sv[e] & 0xffff0000u) * __uint_as_float(uv[e] & 0xffff0000u));
                *(u32x4*)((bf16_t*)(ws + WS_FOGO) + (size_t)(row0 + r) * DM + FW + col) = w; } }
        LDS_WAIT(); __syncthreads();
    }
}

struct Args { const float* in[27]; float* out; unsigned char* ws; int ph_lo, ph_hi; };
typedef const __attribute__((address_space(4))) Args* ArgsP;
__device__ __forceinline__ ArgsP get_args() { ArgsP p = (ArgsP)__builtin_amdgcn_kernarg_segment_ptr(); asm volatile("" : "+s"(p)); return p; }
enum { I_XP = 0, I_XS, I_MEM, I_CFK, I_CFV, I_CFL, I_CMK, I_CMV, I_WIN, I_BF, I_SLG, I_SLB, I_WS, I_BS, I_WOUT, I_L1G, I_L1B, I_WMQ, I_WMK, I_WMV, I_WMO, I_L2G, I_L2B, I_WUP, I_WDN, I_L3G, I_L3B };

constexpr int NORM_CHUNKS = NBS * 128, NORM_SPLIT = 1280;
__device__ __forceinline__ void cache_norms(const float* cfk, unsigned* kn, int c0, int c1, int gw, int NGW, int lane) {
    for (int c = c0 + gw; c < c1; c += NGW) { const int bs = c >> 7; const float* rp = cfk + ((size_t)bs * PAST + (size_t)(c & 127) * 32) * FW + lane * 16; float mx = 0.f;
#pragma unroll 8
        for (int r = 0; r < 32; ++r) { const f32x4 a = *(const f32x4*)(rp + (size_t)r * FW), b = *(const f32x4*)(rp + (size_t)r * FW + 4), c4 = *(const f32x4*)(rp + (size_t)r * FW + 8), d = *(const f32x4*)(rp + (size_t)r * FW + 12);
            float ss = ((a[0] * a[0] + a[1] * a[1]) + (a[2] * a[2] + a[3] * a[3])) + ((b[0] * b[0] + b[1] * b[1]) + (b[2] * b[2] + b[3] * b[3])) + ((c4[0] * c4[0] + c4[1] * c4[1]) + (c4[2] * c4[2] + c4[3] * c4[3])) + ((d[0] * d[0] + d[1] * d[1]) + (d[2] * d[2] + d[3] * d[3]));
            ss += __shfl_xor(ss, 1); ss += __shfl_xor(ss, 2); ss += __shfl_xor(ss, 4); mx = fmaxf(mx, ss); }
        if ((lane & 7) == 0) atomicMax(kn + bs * FH + (lane >> 3), __float_as_uint(mx)); }
}

__device__ __forceinline__ void p0_prologue(Frame& F, ArgsP Ap) {
    unsigned char* ws = Ap->ws;
    int tidp_ = F.wave * 64 + lane_id(); asm volatile("" : "+v"(tidp_)); const int tidp = tidp_;
    const int gw = F.vcu * NWAVES + F.wave, NGW = F.G * NWAVES, lane = tidp & 63;
    const size_t gt = (size_t)blockIdx.x * (NWAVES * 64) + tidp, NGT = (size_t)F.G * (NWAVES * 64);
    LAS float* wf = (LAS float*)F.lds;
    { const float* w_in = Ap->in[I_WIN];
      for (int idx = tidp; idx < DM * FH; idx += NWAVES * 64) { const int k = idx >> 3, h = idx & 7; wf[h * DM + k] = w_in[(size_t)k * INC + 3 * FW + h]; } }
    LDS_WAIT(); __syncthreads();
    { const float* xp = Ap->in[I_XP]; const float* xs = Ap->in[I_XS]; bf16_t* XB = (bf16_t*)(ws + WS_XB); const float bfv = Ap->in[I_BF][lane >> 3];
      f32x4 vn[8];
      if (gw < MT) { const float* xr = (gw < MP ? xp + (size_t)gw * DM : xs + (size_t)(gw - MP) * DM) + 4 * lane;
#pragma unroll
          for (int j = 0; j < 8; ++j) vn[j] = *(const f32x4*)(xr + 256 * j); }
#pragma unroll 1
      for (int m = gw; m < MT; m += NGW) {
          f32x4 v[8];
#pragma unroll
          for (int j = 0; j < 8; ++j) v[j] = vn[j];
          { const int m2 = m + NGW; if (m2 < MT) { const float* xr = (m2 < MP ? xp + (size_t)m2 * DM : xs + (size_t)(m2 - MP) * DM) + 4 * lane;
#pragma unroll
              for (int j = 0; j < 8; ++j) vn[j] = *(const f32x4*)(xr + 256 * j); } }
#pragma unroll
          for (int j = 0; j < 8; ++j) { u32x2 w; w.x = pk2(v[j][0], v[j][1]); w.y = pk2(v[j][2], v[j][3]); *(u32x2*)(XB + (size_t)m * DM + 256 * j + 4 * lane) = w; }
          float z[FH];
#pragma unroll
          for (int h = 0; h < FH; ++h) { float a = 0.f;
#pragma unroll
              for (int j = 0; j < 8; ++j) { const f32x4 w4 = *(const LAS f32x4*)(wf + h * DM + 256 * j + 4 * lane); a = fmaf(v[j][0], w4[0], a); a = fmaf(v[j][1], w4[1], a); a = fmaf(v[j][2], w4[2], a); a = fmaf(v[j][3], w4[3], a); }
              z[h] = a; }
          float y4[4], y2[2], zz;
          { const bool up = (lane & 32) != 0;
#pragma unroll
            for (int i = 0; i < 4; ++i) { const float keep = up ? z[4 + i] : z[i], give = up ? z[i] : z[4 + i]; y4[i] = keep + __shfl_xor(give, 32); } }
          { const bool up = (lane & 16) != 0;
#pragma unroll
            for (int i = 0; i < 2; ++i) { const float keep = up ? y4[2 + i] : y4[i], give = up ? y4[i] : y4[2 + i]; y2[i] = keep + __shfl_xor(give, 16); } }
          { const bool up = (lane & 8) != 0; const float keep = up ? y2[1] : y2[0], give = up ? y2[0] : y2[1]; zz = keep + __shfl_xor(give, 8); }
          zz += __shfl_xor(zz, 4); zz += __shfl_xor(zz, 2); zz += __shfl_xor(zz, 1);
          if ((lane & 7) == 0) { const int h = lane >> 3; const float lf = log_sigmoid_f(zz + bfv); Ap->out[(m < MP ? O_FLP + (size_t)m * FH : O_FLS + (size_t)(m - MP) * FH) + h] = lf; }
      } }
    __syncthreads();
    cvt_flat(Ap->in[I_MEM], (bf16_t*)(ws + WS_MEMB), (size_t)NB * NMEM * DM, 40, 0, gt, NGT);
    cvt_flat(Ap->in[I_CMK], (bf16_t*)(ws + WS_CMK), (size_t)NBS * NMEM * DM, 40, 0, gt, NGT);
    cvt_rowscale(Ap->in[I_WMQ], (bf16_t*)(ws + WS_WMQN), Ap->in[I_L1G], (size_t)DM * DM, gt, NGT);
    cache_norms(Ap->in[I_CFK], (unsigned*)(ws + WS_CTL) + CW_KN2C, 0, NORM_CHUNKS, gw, NGW, lane);
    for (size_t e = gt * 8; e < (size_t)NBS * 32 * FW; e += NGT * 8) { const size_t d = (e >> 15) * ((size_t)SKS * FW) + (size_t)(PAST + TS) * FW + (e & 32767);
        *(u32x4*)((bf16_t*)(ws + WS_KS) + d) = (u32x4){0u, 0u, 0u, 0u}; *(u32x4*)((bf16_t*)(ws + WS_VS) + d) = (u32x4){0u, 0u, 0u, 0u}; }
    LAS float* scr = (LAS float*)(F.lds + F.wave * 16384);
    {
        constexpr int I_IN = (DM / 64) * (NIN / 32), I_SQ = (DM / 64) * (DM / 32), I_UP = (DM / 64) * (DFF / 32), I_DN = (DFF / 64) * (DM / 32), I_CV = (NMEM / 64) * (DM / 32);
        constexpr int NITEMS = I_IN + 5 * I_SQ + I_UP + I_DN + NBS * I_CV;
        auto decode = [&](int it) -> TItem { TItem d; int r = it; d.gv = nullptr; d.bv = nullptr; d.cs = nullptr; d.bw = nullptr; d.fold = 0;
            if (r < I_UP) { const int nblk = DFF / 32, kb = r / nblk, n0 = 32 * (r % nblk); d.W = Ap->in[I_WUP]; d.WT = (bf16_t*)(ws + WS_WUP); d.ldw = DFF; d.K = DM; d.k0 = 64 * kb; d.nsrc = n0; d.ndst = n0;
                d.gv = Ap->in[I_L2G]; d.bv = Ap->in[I_L2B]; d.cs = (float*)(ws + WS_CTL) + CW_CS2; d.bw = (float*)(ws + WS_CTL) + CW_BW2; d.fold = 1; return d; } r -= I_UP;
            if (r < I_DN) { const int nblk = DM / 32, kb = r / nblk, n0 = 32 * (r % nblk); d.W = Ap->in[I_WDN]; d.WT = (bf16_t*)(ws + WS_WDN); d.ldw = DM; d.K = DFF; d.k0 = 64 * kb; d.nsrc = n0; d.ndst = n0; return d; } r -= I_DN;
            if (r < I_IN) { const int nblk = NIN / 32, kb = r / nblk, n0 = 32 * (r % nblk); d.W = Ap->in[I_WIN]; d.WT = (bf16_t*)(ws + WS_WIN); d.ldw = INC; d.K = DM; d.k0 = 64 * kb; d.nsrc = n0 + (n0 >= 3 * FW ? FH : 0); d.ndst = n0; return d; } r -= I_IN;
            if (r < I_SQ) { const int nblk = DM / 32, kb = r / nblk, n0 = 32 * (r % nblk); d.W = Ap->in[I_WMQ]; d.WT = (bf16_t*)(ws + WS_WMQ); d.ldw = DM; d.K = DM; d.k0 = 64 * kb; d.nsrc = n0; d.ndst = n0;
                d.gv = Ap->in[I_L1G]; d.bv = Ap->in[I_L1B]; d.cs = (float*)(ws + WS_CTL) + CW_CS1; d.bw = (float*)(ws + WS_CTL) + CW_BW1; d.fold = 1; return d; } r -= I_SQ;
            if (r < 4 * I_SQ) { const int wsel = r / I_SQ, q = r - wsel * I_SQ, nblk = DM / 32, kb = q / nblk, n0 = 32 * (q % nblk);
                d.W = Ap->in[wsel == 0 ? I_WOUT : wsel == 1 ? I_WMK : wsel == 2 ? I_WMV : I_WMO];
                d.WT = (bf16_t*)(ws + (wsel == 0 ? WS_WOUT : wsel == 1 ? WS_WMK : wsel == 2 ? WS_WMV : WS_WMO)); d.ldw = DM; d.K = DM; d.k0 = 64 * kb; d.nsrc = n0; d.ndst = n0; return d; } r -= 4 * I_SQ;
            { const int bs = r / I_CV, q = r - bs * I_CV, nblk = DM / 32, kb = q / nblk, n0 = 32 * (q % nblk);
              d.W = Ap->in[I_CMV] + (size_t)bs * NMEM * DM; d.WT = (bf16_t*)(ws + WS_CMVT) + (size_t)bs * DM * NMEM; d.ldw = DM; d.K = NMEM; d.k0 = 64 * kb; d.nsrc = n0; d.ndst = n0; return d; } };
        if (gw < NITEMS) {
            TItem cur = decode(gw); f32x4 tv[8]; titem_load(cur, tv, lane);
#pragma unroll 1
            for (int it = gw; it < NITEMS; it += NGW) { const bool more = it + NGW < NITEMS; TItem nxt = cur; f32x4 tn[8];
                if (more) { nxt = decode(it + NGW); titem_load(nxt, tn, lane); }
                if (cur.fold) titem_finish<true>(cur, tv, scr, lane); else titem_finish<false>(cur, tv, scr, lane);
                if (more) { cur = nxt;
#pragma unroll
                    for (int i = 0; i < 8; ++i) tv[i] = tn[i]; } }
        }
    }
}

__device__ __forceinline__ void cumsum_unit(Frame& F, int seq, ArgsP A) {
    LAS double* tot = (LAS double*)F.lds; LAS double* part = tot + 512; LAS double* pexc = part + 64;
    int tidc_ = F.wave * 64 + lane_id(); asm volatile("" : "+v"(tidc_)); const int tid = tidc_; const bool samp = seq >= NB * FH; const int s = samp ? seq - NB * FH : seq, bb = s >> 3, h = s & 7;
    const float* src = (samp ? A->in[I_CFL] + ((size_t)bb * PAST) * FH + h : A->out + O_FLP + ((size_t)bb * SEQ) * FH + h) + (size_t)(8 * tid) * FH;
    float* dst = samp ? (float*)(A->ws + WS_KXS) + (size_t)s * SKS : (float*)(A->ws + WS_KXP) + (size_t)s * SEQ;
    float x0 = src[0], x1 = src[FH], x2 = src[2 * FH], x3 = src[3 * FH], x4 = src[4 * FH], x5 = src[5 * FH], x6 = src[6 * FH], x7 = src[7 * FH];
    tot[tid] = (((double)x0 + (double)x1) + ((double)x2 + (double)x3)) + (((double)x4 + (double)x5) + ((double)x6 + (double)x7));
    LDS_WAIT(); __syncthreads();
    if (tid < 64) { double a = 0.0;
#pragma unroll 1
        for (int j = 0; j < 8; ++j) a += tot[8 * tid + j];
        part[tid] = a; }
    LDS_WAIT(); __syncthreads();
    if (tid == 0) { double a = 0.0;
#pragma unroll 8
        for (int j = 0; j < 64; ++j) { pexc[j] = a; a += part[j]; } pexc[64] = a; }
    LDS_WAIT(); __syncthreads();
    double c = pexc[tid >> 3];
#pragma unroll 1
    for (int j = 0; j < (tid & 7); ++j) c += tot[8 * (tid >> 3) + j];
    constexpr double INV = -1.0 / (double)FOX_SCALE;
    float* dp = dst + 8 * tid;
    c += (double)x0; dp[0] = (float)(c * INV); c += (double)x1; dp[1] = (float)(c * INV); c += (double)x2; dp[2] = (float)(c * INV); c += (double)x3; dp[3] = (float)(c * INV);
    c += (double)x4; dp[4] = (float)(c * INV); c += (double)x5; dp[5] = (float)(c * INV); c += (double)x6; dp[6] = (float)(c * INV); c += (double)x7; dp[7] = (float)(c * INV);
    if (samp && tid < 64) {
        LAS float* sv = (LAS float*)(pexc + 66);
        if (tid < TS) sv[tid] = (A->out + O_FLS + ((size_t)bb * TS) * FH + h)[(size_t)tid * FH];
        LDS_WAIT();
        if (tid < TS) { double c2 = pexc[64];
#pragma unroll 1
            for (int j = 0; j <= tid; ++j) c2 += (double)sv[j];
            dst[PAST + tid] = (float)(c2 * INV); }
        else dst[PAST + tid] = 0.f;
    }
    __syncthreads();
}

struct FoxGen {
    unsigned char* ws; int vcu; float* outp;
    __device__ __forceinline__ fox::BlockRef operator()(int i) const {
        fox::BlockRef br;
        if (i < 4) { const int item = vcu + 256 * (i >> 1), bh = item >> 3, x = item & 7, qb = (i & 1) ? 15 - x : x, b = bh >> 3, h = bh & 7;
            const size_t r0 = (size_t)b * SEQ + (size_t)qb * 256;
            br.Q = (const fox::bf16*)(ws + WS_QB) + r0 * FW + h * FD; br.K = (const fox::bf16*)(ws + WS_KB) + (size_t)b * SEQ * FW + h * FD; br.V = (const fox::bf16*)(ws + WS_VB) + (size_t)b * SEQ * FW + h * FD;
            br.O = (fox::bf16*)(ws + WS_FOGO) + r0 * DM + h * FD; br.KX = (const float*)(ws + WS_KXP) + (size_t)bh * SEQ; br.P0 = qb * 256; br.skv = SEQ; br.nvalid = 256; br.nidx = bh; }
        else { const int bs = vcu >> 3, h = vcu & 7; const size_t r0 = (size_t)MP + (size_t)bs * TS;
            br.Q = (const fox::bf16*)(ws + WS_QB) + r0 * FW + h * FD; br.K = (const fox::bf16*)(ws + WS_KS) + (size_t)bs * SKS * FW + h * FD; br.V = (const fox::bf16*)(ws + WS_VS) + (size_t)bs * SKS * FW + h * FD;
            br.O = (fox::bf16*)(ws + WS_FOGO) + r0 * DM + h * FD; br.KX = (const float*)(ws + WS_KXS) + (size_t)vcu * SKS; br.P0 = PAST; br.skv = SKS; br.nvalid = TS; br.nidx = 64 + vcu; }
        return br;
    }
};

constexpr int N_PHASES = 13;
__global__ void __launch_bounds__(NWAVES * 64, 2) fwd(Args args) {
    extern __shared__ __attribute__((aligned(16))) unsigned char lds[];
    Frame F;
    F.lds = (LAS unsigned char*)lds;
    F.wave = __builtin_amdgcn_readfirstlane((int)threadIdx.x >> 6);
    F.G = gridDim.x; { const int bx = blockIdx.x; F.vcu = (F.G % 8 == 0) ? (bx % 8) * (F.G / 8) + bx / 8 : bx; }
    unsigned char* ws;
#if MK_N_LAUNCHES == 1
    constexpr int lo = 0, hi = N_PHASES;
    { ArgsP a0 = get_args(); ws = a0->ws; }
#else
    int lo, hi;
    { ArgsP a0 = get_args(); ws = a0->ws; lo = a0->ph_lo; hi = a0->ph_hi; }
#endif
#define out (get_args()->out)
    for (int u = (int)threadIdx.x; u < (LDS_BYTES - LDSCTL_OFF) / 4; u += NWAVES * 64) ((LAS unsigned*)(F.lds + LDSCTL_OFF))[u] = 0u;
    __syncthreads();
    if (MK_N_LAUNCHES == 1) (void)xcd_barrier_post((unsigned*)((gu32*)(ws + WS_CTL) + CW_BAR), (volatile LAS unsigned*)(F.lds + MISC_OFF) + 8, threadIdx.x == 0);
#define GRID_BARRIER() do { XcdBarrier b_; b_.bar = (unsigned*)((gu32*)(ws + WS_CTL) + CW_BAR); b_.x = xb_xcc_id(); b_.st = (volatile LAS unsigned*)(F.lds + MISC_OFF) + 8; b_.G = (unsigned)F.G; b_.t0 = (F.wave == 0 && lane_id() == 0); xcd_barrier(b_); } while (0)
#ifndef PH_MASK
#define PH_MASK 0x1FFF
#endif
#define IN(k) (((PH_MASK >> (k)) & 1) && lo <= (k) && (k) < hi)
#define SEAM(k) do { if (IN(k) && IN((k) + 1)) GRID_BARRIER(); } while (0)
#ifndef PROBE_REPEAT
#define PROBE_REPEAT 0
#endif
#define R_ (out + O_YP)
#define WSB(off) ((bf16_t*)(ws + (off)))
    const int bx = (int)blockIdx.x;

    if (IN(0)) { p0_prologue(F, get_args()); }
#if (PROBE_REPEAT >> 0) & 1
    GRID_BARRIER(); if (IN(0)) { p0_prologue(F, get_args()); }
#endif
    SEAM(0);
    if (IN(1)) {
        if (F.vcu < NB * FH + NBS * FH) cumsum_unit(F, F.vcu, get_args());
        ProbP1 S{DM, DM, DM, ws, F.G, bx};
        EpiP1 E{WSB(WS_QB), WSB(WS_KB), WSB(WS_VB), WSB(WS_UB), WSB(WS_GB), WSB(WS_KS), WSB(WS_VS), (bf16_t*)(ws + WS_MKB), (bf16_t*)(ws + WS_MVB), out, (unsigned*)(ws + WS_CTL), (LAS float*)(F.lds + XCH_OFF)};
        pg8::gemm_phase<EpiP1, ProbP1>(F.lds, S, E, F.wave);
    }
#if (PROBE_REPEAT >> 1) & 1
    GRID_BARRIER();
    if (IN(1)) {
        if (F.vcu < NB * FH + NBS * FH) cumsum_unit(F, F.vcu, get_args());
        ProbP1 S{DM, DM, DM, ws, F.G, bx};
        EpiP1 E{WSB(WS_QB), WSB(WS_KB), WSB(WS_VB), WSB(WS_UB), WSB(WS_GB), WSB(WS_KS), WSB(WS_VS), (bf16_t*)(ws + WS_MKB), (bf16_t*)(ws + WS_MVB), out, (unsigned*)(ws + WS_CTL), (LAS float*)(F.lds + XCH_OFF)};
        pg8::gemm_phase<EpiP1, ProbP1>(F.lds, S, E, F.wave);
    }
#endif
    SEAM(1);
    if (IN(2)) {
#ifndef NO_FOX
        {
            const int nblk = F.vcu < NBS * FH ? 5 : 4;
            const FoxGen gen{ws, F.vcu, out};
            fox::Seam S;
            {
              const int ln = lane_id(); const float* nq = (const float*)(ws + WS_CTL) + CW_QN2; const float* nk = (const float*)(ws + WS_CTL) + CW_KN2; const float* nc = (const float*)(ws + WS_CTL) + CW_KN2C;
#pragma unroll
              for (int i = 0; i < 5; ++i) if (i < nblk) { const fox::BlockRef br = gen(i); const int ni = br.nidx;
                  const float q2 = (nq[ni * 4] + nq[ni * 4 + 1]) + (nq[ni * 4 + 2] + nq[ni * 4 + 3]); float k2 = (nk[ni * 4] + nk[ni * 4 + 1]) + (nk[ni * 4 + 2] + nk[ni * 4 + 3]);
                  if (ni >= 64) k2 = fmaxf(k2, nc[ni - 64]);
                  const float bound = 2.0f * sqrtf(q2) * sqrtf(k2) * 1.01f + PRUNE_T / FOX_SCALE;
                  const int jl = fox::fox_jlo(br.KX, br.P0, bound, ln);
                  if (F.wave == 0 && ln == 0) ((LAS int*)(F.lds + fox::LDS_JLO))[i] = jl; }
              LDS_WAIT(); __syncthreads();
              if (F.vcu < NBS * FH) {
                  const int bs = F.vcu >> 3, h = F.vcu & 7, r_lo = ((LAS int*)(F.lds + fox::LDS_JLO))[4] * 64; ArgsP A = get_args();
                  const float* ck = A->in[I_CFK] + ((size_t)bs * PAST) * FW + h * FD; const float* cv = A->in[I_CFV] + ((size_t)bs * PAST) * FW + h * FD;
                  bf16_t* ks = WSB(WS_KS) + ((size_t)bs * SKS) * FW + h * FD; bf16_t* vs = WSB(WS_VS) + ((size_t)bs * SKS) * FW + h * FD;
#pragma unroll 4
                  for (int idx = F.wave * 64 + ln; idx < (PAST - r_lo) * 16; idx += NWAVES * 64) { const size_t o = (size_t)(r_lo + (idx >> 4)) * FW + (idx & 15) * 8;
                      const f32x4 a = *(const f32x4*)(ck + o), b = *(const f32x4*)(ck + o + 4), c = *(const f32x4*)(cv + o), d = *(const f32x4*)(cv + o + 4);
                      u32x4 w; w.x = pk2(a[0], a[1]); w.y = pk2(a[2], a[3]); w.z = pk2(b[0], b[1]); w.w = pk2(b[2], b[3]); *(u32x4*)(ks + o) = w;
                      w.x = pk2(c[0], c[1]); w.y = pk2(c[2], c[3]); w.z = pk2(d[0], d[1]); w.w = pk2(d[2], d[3]); *(u32x4*)(vs + o) = w; }
                  VM_WAIT(); __builtin_amdgcn_fence(__ATOMIC_ACQUIRE, "agent"); VM_WAIT(); __syncthreads();
              }
            }
            fox::prime(gen(0), (char*)lds, S, F.wave);
#pragma unroll 1
            for (int i = 0; i < nblk; ++i) fox::block(gen, i, nblk, (char*)lds, S, F.wave);
        }
#endif
        __syncthreads();
#ifndef NO_SGU
        {
#pragma unroll 1
            for (int it = 0; it < 3; ++it) {
                int u, g0 = 0, g1 = 4;
                if (it == 0) { u = F.vcu; if (F.vcu < 128) g1 = 3; }
                else if (it == 1) { if (F.vcu < 128) break; u = F.vcu - 128; g0 = 3; }
                else { if (F.vcu >= 128 + NBS) break; u = 128 + F.vcu; }
                if (u < 256) sgu_unit<128>(F, ws, get_args, 128 * u, nullptr, g0, g1); else sgu_unit<TS>(F, ws, get_args, MP + TS * (u - 256), out + O_GVS);
            }
        }
#endif
    }
#if (PROBE_REPEAT >> 2) & 1
    GRID_BARRIER();
    if (IN(2)) {
#if !defined(NO_FOX) && (PROBE_P2_SUB & 1)
        {
            const int nblk = F.vcu < NBS * FH ? 5 : 4;
            const FoxGen gen{ws, F.vcu, out};
            fox::Seam S;
            {
              const int ln = lane_id(); const float* nq = (const float*)(ws + WS_CTL) + CW_QN2; const float* nk = (const float*)(ws + WS_CTL) + CW_KN2; const float* nc = (const float*)(ws + WS_CTL) + CW_KN2C;
#pragma unroll
              for (int i = 0; i < 5; ++i) if (i < nblk) { const fox::BlockRef br = gen(i); const int ni = br.nidx;
                  const float q2 = (nq[ni * 4] + nq[ni * 4 + 1]) + (nq[ni * 4 + 2] + nq[ni * 4 + 3]); float k2 = (nk[ni * 4] + nk[ni * 4 + 1]) + (nk[ni * 4 + 2] + nk[ni * 4 + 3]);
                  if (ni >= 64) k2 = fmaxf(k2, nc[ni - 64]);
                  const float bound = 2.0f * sqrtf(q2) * sqrtf(k2) * 1.01f + PRUNE_T / FOX_SCALE;
                  const int jl = fox::fox_jlo(br.KX, br.P0, bound, ln);
                  if (F.wave == 0 && ln == 0) ((LAS int*)(F.lds + fox::LDS_JLO))[i] = jl; }
              LDS_WAIT(); __syncthreads();
              if (F.vcu < NBS * FH) {
                  const int bs = F.vcu >> 3, h = F.vcu & 7, r_lo = ((LAS int*)(F.lds + fox::LDS_JLO))[4] * 64; ArgsP A = get_args();
                  const float* ck = A->in[I_CFK] + ((size_t)bs * PAST) * FW + h * FD; const float* cv = A->in[I_CFV] + ((size_t)bs * PAST) * FW + h * FD;
                  bf16_t* ks = WSB(WS_KS) + ((size_t)bs * SKS) * FW + h * FD; bf16_t* vs = WSB(WS_VS) + ((size_t)bs * SKS) * FW + h * FD;
#pragma unroll 4
                  for (int idx = F.wave * 64 + ln; idx < (PAST - r_lo) * 16; idx += NWAVES * 64) { const size_t o = (size_t)(r_lo + (idx >> 4)) * FW + (idx & 15) * 8;
                      const f32x4 a = *(const f32x4*)(ck + o), b = *(const f32x4*)(ck + o + 4), c = *(const f32x4*)(cv + o), d = *(const f32x4*)(cv + o + 4);
                      u32x4 w; w.x = pk2(a[0], a[1]); w.y = pk2(a[2], a[3]); w.z = pk2(b[0], b[1]); w.w = pk2(b[2], b[3]); *(u32x4*)(ks + o) = w;
                      w.x = pk2(c[0], c[1]); w.y = pk2(c[2], c[3]); w.z = pk2(d[0], d[1]); w.w = pk2(d[2], d[3]); *(u32x4*)(vs + o) = w; }
                  VM_WAIT(); __builtin_amdgcn_fence(__ATOMIC_ACQUIRE, "agent"); VM_WAIT(); __syncthreads();
              }
            }
            fox::prime(gen(0), (char*)lds, S, F.wave);
#pragma unroll 1
            for (int i = 0; i < nblk; ++i) fox::block(gen, i, nblk, (char*)lds, S, F.wave);
        }
#endif
        __syncthreads();
#if !defined(NO_SGU) && (PROBE_P2_SUB & 2)
        {
#pragma unroll 1
            for (int u = F.vcu; u < 256 + NBS; u += (F.vcu >= 128 && F.vcu < 128 + NBS) ? 128 : 512) {
                if (u < 256) sgu_unit<128>(F, ws, get_args, 128 * u, nullptr); else sgu_unit<TS>(F, ws, get_args, MP + TS * (u - 256), out + O_GVS);
            }
        }
#endif
    }
#endif
    SEAM(2);
    if (IN(3)) {
        ProbMain S{DM, DM, DM, WSB(WS_FOGO), (const bf16_t*)(ws + WS_WOUT), MP / 256, DM / 256, F.G, bx};
        ArgsP A = get_args(); EpiResLn<true, true> E{A->in[I_XP], WSB(WS_XLB), nullptr, (float*)(ws + WS_STAT1), nullptr, nullptr, (LAS float*)(F.lds + XCH_OFF)};
        pg8::gemm_phase<EpiResLn<true, true>, ProbMain>(F.lds, S, E, F.wave);
        ProbPiece S2{256, DM, DM, WSB(WS_FOGO), (const bf16_t*)(ws + WS_WOUT), 8, DM / 256, F.G, bx};
        EpiSlab E2{(float*)(ws + WS_SLAB), DM};
        pg8::gemm_phase<EpiSlab, ProbPiece>(F.lds, S2, E2, F.wave);
    }
#if (PROBE_REPEAT >> 3) & 1
    GRID_BARRIER();
    if (IN(3)) {
        ProbMain S{DM, DM, DM, WSB(WS_FOGO), (const bf16_t*)(ws + WS_WOUT), MP / 256, DM / 256, F.G, bx};
        ArgsP A = get_args(); EpiResLn<true, true> E{A->in[I_XP], WSB(WS_XLB), nullptr, (float*)(ws + WS_STAT1), nullptr, nullptr, (LAS float*)(F.lds + XCH_OFF)};
        pg8::gemm_phase<EpiResLn<true, true>, ProbMain>(F.lds, S, E, F.wave);
        ProbPiece S2{256, DM, DM, WSB(WS_FOGO), (const bf16_t*)(ws + WS_WOUT), 8, DM / 256, F.G, bx};
        EpiSlab E2{(float*)(ws + WS_SLAB), DM};
        pg8::gemm_phase<EpiSlab, ProbPiece>(F.lds, S2, E2, F.wave);
    }
#endif
    SEAM(3);
    if (IN(4)) { { ArgsP A = get_args(); sample_combine<1>(F, R_, WSB(WS_XLB), (float*)(ws + WS_STAT1), A->in[I_XS], nullptr, nullptr, nullptr, nullptr, (const float*)(ws + WS_SLAB), 8); }
        csm_rows(F, WSB(WS_MKB), (const float*)(ws + WS_CTL) + CW_CS1, (const float*)(ws + WS_CTL) + CW_BW1, (float*)(ws + WS_CSM));
    }
    SEAM(4);
    if (IN(5)) {
        ProbQs S1{DM, DM, DM, ws, F.G, bx};
        EpiLnBf16<0, true> E1{WSB(WS_QM), DM, (const float*)(ws + WS_STAT1), (const float*)(ws + WS_CTL) + CW_CS1, (const float*)(ws + WS_CTL) + CW_BW1};
        pg8::gemm_phase<EpiLnBf16<0, true>, ProbQs, true>(F.lds, S1, E1, F.wave);
        ProbM S0{MD, DM, DM, ws, F.G, bx}; EpiBf16<0> E0{WSB(WS_MT), DM};
        pg8::gemm_phase<EpiBf16<0>, ProbM>(F.lds, S0, E0, F.wave);
        ProbVW S{MD, DM, DM, ws, F.G, bx}; EpiBf16<0> E{WSB(WS_VWT), MH * NMEM};
        pg8::gemm_phase<EpiBf16<0>, ProbVW>(F.lds, S, E, F.wave);
    }
    SEAM(5);
    if (IN(6)) {
        ProbS2 S{DM, DM, DM, ws, F.G, bx};
        EpiSm<true> E{WSB(WS_PB), (LAS float*)(F.lds + XCH_OFF), (const float*)(ws + WS_STAT1), (const float*)(ws + WS_CSM)};
        pg8::gemm_phase<EpiSm<true>, ProbS2>(F.lds, S, E, F.wave);
        ProbS S2{MD, DM, DM, ws, F.G, bx};
        EpiSm<false> E2{WSB(WS_PB), (LAS float*)(F.lds + XCH_OFF), nullptr, nullptr};
        pg8::gemm_phase<EpiSm<false>, ProbS>(F.lds, S2, E2, F.wave);
    }
#if (PROBE_REPEAT >> 6) & 1
    GRID_BARRIER();
    if (IN(6)) {
        ProbS2 S{DM, DM, DM, ws, F.G, bx};
        EpiSm<true> E{WSB(WS_PB), (LAS float*)(F.lds + XCH_OFF), (const float*)(ws + WS_STAT1), (const float*)(ws + WS_CSM)};
        pg8::gemm_phase<EpiSm<true>, ProbS2>(F.lds, S, E, F.wave);
        ProbS S2{MD, DM, DM, ws, F.G, bx};
        EpiSm<false> E2{WSB(WS_PB), (LAS float*)(F.lds + XCH_OFF), nullptr, nullptr};
        pg8::gemm_phase<EpiSm<false>, ProbS>(F.lds, S2, E2, F.wave);
    }
#endif
    SEAM(6);
    if (IN(7)) {
        ProbO S{MH * NMEM, MH * NMEM, MH * NMEM, ws, F.G, bx};
        ArgsP A = get_args(); EpiResLn<false, true> E{nullptr, WSB(WS_XLB), (const float*)(ws + WS_STAT1), (float*)(ws + WS_STAT2), A->in[I_L1G], A->in[I_L1B], (LAS float*)(F.lds + XCH_OFF)};
        pg8::gemm_phase<EpiResLn<false, true>, ProbO>(F.lds, S, E, F.wave);
        ProbPV S2{NMEM, MH * NMEM, NMEM, ws, F.G, bx};
        EpiPV E2{WSB(WS_OM)};
        pg8::gemm_phase<EpiPV, ProbPV>(F.lds, S2, E2, F.wave);
    }
    SEAM(7);
    if (IN(8)) {
        ProbPiece S2{256, DM, DM, WSB(WS_OM), (const bf16_t*)(ws + WS_WMO), 8, DM / 256, F.G, bx};
        EpiSlab E2{(float*)(ws + WS_SLAB), DM};
        pg8::gemm_phase<EpiSlab, ProbPiece>(F.lds, S2, E2, F.wave);
    }
    SEAM(8);
    if (IN(9)) { ArgsP A = get_args(); sample_combine<2>(F, R_, WSB(WS_XLB), (float*)(ws + WS_STAT2), nullptr, A->in[I_L1G], A->in[I_L1B], nullptr, nullptr, (const float*)(ws + WS_SLAB), 8); }
    SEAM(9);
    if (IN(10)) {
        ProbMain S{DM, DM, DM, WSB(WS_XLB), (const bf16_t*)(ws + WS_WUP), MT / 256, DFF / 256, F.G, bx};
        EpiLnBf16<1> E{WSB(WS_HB), DFF, (const float*)(ws + WS_STAT2), (const float*)(ws + WS_CTL) + CW_CS2, (const float*)(ws + WS_CTL) + CW_BW2};
        pg8::gemm_phase<EpiLnBf16<1>, ProbMain>(F.lds, S, E, F.wave);
    }
#if (PROBE_REPEAT >> 10) & 1
    GRID_BARRIER();
#ifdef PROBE_FIXED_OPERANDS
    if (IN(10)) {
        ProbMainFix S{{DM, DM, DM, WSB(WS_XLB), (const bf16_t*)(ws + WS_WUP), MT / 256, DFF / 256, F.G, bx}};
        EpiLnBf16<1> E{WSB(WS_HB), DFF, (const float*)(ws + WS_STAT2), (const float*)(ws + WS_CTL) + CW_CS2, (const float*)(ws + WS_CTL) + CW_BW2};
        pg8::gemm_phase<EpiLnBf16<1>, ProbMainFix>(F.lds, S, E, F.wave);
    }
    GRID_BARRIER();
#endif
    if (IN(10)) {
        ProbMain S{DM, DM, DM, WSB(WS_XLB), (const bf16_t*)(ws + WS_WUP), MT / 256, DFF / 256, F.G, bx};
        EpiLnBf16<1> E{WSB(WS_HB), DFF, (const float*)(ws + WS_STAT2), (const float*)(ws + WS_CTL) + CW_CS2, (const float*)(ws + WS_CTL) + CW_BW2};
        pg8::gemm_phase<EpiLnBf16<1>, ProbMain>(F.lds, S, E, F.wave);
    }
#endif
    SEAM(10);
    if (IN(11)) {
        ProbMain S{DFF, DFF, DFF, WSB(WS_HB), (const bf16_t*)(ws + WS_WDN), MP / 256, DM / 256, F.G, bx, 4};
        ArgsP A = get_args(); EpiResLn<false, false> E{nullptr, WSB(WS_XLB), (const float*)(ws + WS_STAT2), nullptr, A->in[I_L2G], A->in[I_L2B], (LAS float*)(F.lds + XCH_OFF)};
        pg8::gemm_phase<EpiResLn<false, false>, ProbMain>(F.lds, S, E, F.wave);
        ProbPiece S2{512, DFF, DFF, WSB(WS_HB), (const bf16_t*)(ws + WS_WDN), 16, DM / 256, F.G, bx};
        EpiSlab E2{(float*)(ws + WS_SLAB), DM};
        pg8::gemm_phase<EpiSlab, ProbPiece>(F.lds, S2, E2, F.wave);
    }
    SEAM(11);
    if (IN(12)) { ArgsP A = get_args();
        sample_combine<3>(F, R_, nullptr, nullptr, nullptr, A->in[I_L2G], A->in[I_L2B], A->in[I_L3G], A->in[I_L3B], (const float*)(ws + WS_SLAB), 16);
        ln_prompt(F, WSB(WS_XLB), R_, A->in[I_L3G], A->in[I_L3B]); }
#undef IN
#undef SEAM
#undef out
}

extern "C" void kernel_launch(void* const* d_in, const int* in_sizes, int n_in, void* d_out, int out_size, void* d_ws, size_t ws_size, hipStream_t stream) {
    static int grid = 0;
    if (grid == 0) {
        if (n_in != 27 || (size_t)out_size != O_END || ws_size < WS_END) { fprintf(stderr, "kernel_launch: unexpected shapes (n_in %d, out %d, ws %zu)\n", n_in, out_size, ws_size); grid = -1; return; }
        int dev = 0, cus = 0;
        if (hipGetDevice(&dev) != hipSuccess || hipDeviceGetAttribute(&cus, hipDeviceAttributeMultiprocessorCount, dev) != hipSuccess) { grid = -1; return; }
        if (hipFuncSetAttribute((const void*)fwd, hipFuncAttributeMaxDynamicSharedMemorySize, LDS_BYTES) != hipSuccess) { fprintf(stderr, "kernel_launch: hipFuncSetAttribute failed\n"); grid = -1; return; }
        int per_cu = 0;
        if (hipOccupancyMaxActiveBlocksPerMultiprocessor(&per_cu, (const void*)fwd, NWAVES * 64, LDS_BYTES) != hipSuccess || per_cu < 1) fprintf(stderr, "kernel_launch: occupancy query says %d\n", per_cu);
        (void)hipGetLastError();
        grid = cus;
    }
    if (grid < 0) return;
    if (hipMemsetAsync((char*)d_ws + WS_CTL, 0, CTL_ZERO_BYTES, stream) != hipSuccess) return;
    Args a{};
    for (int i = 0; i < 27; ++i) a.in[i] = (const float*)d_in[i];
    a.out = (float*)d_out; a.ws = (unsigned char*)d_ws;
    if (MK_N_LAUNCHES == 1) { a.ph_lo = 0; a.ph_hi = N_PHASES; hipLaunchKernelGGL(fwd, dim3(grid), dim3(NWAVES * 64), LDS_BYTES, stream, a); }
    else for (int li = 0; li < N_PHASES; ++li) { a.ph_lo = li; a.ph_hi = li + 1; hipLaunchKernelGGL(fwd, dim3(grid), dim3(NWAVES * 64), LDS_BYTES, stream, a); }
}
```
